# Optimizing an MI355X kernel written in HIP

```python
import math
import jax, jax.numpy as jnp
from jax import lax
import numpy as np


D_MODEL = 1024
BATCH = 2
SEQ = 8192
DEPTH = 4

N_MIXERS = 4
PLE_DIM = 256
HEAD_DIM = 64
N_HEADS = D_MODEL // HEAD_DIM
ROPE_THETA = 10000.0
NORM_EPS = 1e-6
Q_BLOCK = 128
LRU_WIDTH = D_MODEL
LRU_BLOCKS = N_HEADS
LRU_BLOCK_DIM = LRU_WIDTH // LRU_BLOCKS
CONV_WIDTH = 4
RGLRU_C = 8.0
DIL_PATTERNS = ((128, 1), (512, 4), (2048, 16))
DIFF_HEADS = D_MODEL // (2 * HEAD_DIM)
DIFF_SUBLN_EPS = 1e-5
FFN_HIDDEN = -(-(8 * D_MODEL) // (3 * 256)) * 256
N_A = (DEPTH + 3) // 4
N_B = (DEPTH + 2) // 4
N_C = (DEPTH + 1) // 4
N_D = DEPTH // 4

kernel_name = 'hybrid_interleaved_rglru_dilated_stickbreak_diffattn'


def rmsnorm(x, g, eps=NORM_EPS):
    xf = x.astype(jnp.float32)
    xf = xf * lax.rsqrt(jnp.mean(xf * xf, axis=-1, keepdims=True) + eps)
    return (xf * g.astype(jnp.float32)).astype(x.dtype)


def rope(t, positions):
    hd = t.shape[-1]
    inv = ROPE_THETA ** (-jnp.arange(0, hd, 2, dtype=jnp.float32) / hd)
    ang = positions.astype(jnp.float32)[..., None] * inv
    cos = jnp.cos(ang)[:, :, None, :]
    sin = jnp.sin(ang)[:, :, None, :]
    tf = t.astype(jnp.float32)
    t1, t2 = tf[..., :hd // 2], tf[..., hd // 2:]
    return jnp.concatenate([t1 * cos - t2 * sin, t2 * cos + t1 * sin], axis=-1).astype(t.dtype)


def to_blocks(t):
    B, S, H, e = t.shape
    return t.reshape(B, S // Q_BLOCK, Q_BLOCK, H, e).transpose(1, 0, 2, 3, 4)


def from_blocks(t):
    nb, B, blk, H, e = t.shape
    return t.transpose(1, 0, 2, 3, 4).reshape(B, nb * blk, H, e)


def _lin_rec_combine(c1, c2):
    a1, b1 = c1
    a2, b2 = c2
    return a1 * a2, a2 * b1 + b2


def rglru_block(h, w_in, conv_w, conv_b, gate_r_w, gate_r_b, gate_i_w, gate_i_b, a_param, w_out):
    B, S, _ = h.shape
    u = h @ w_in
    y = jax.nn.gelu(u[..., :LRU_WIDTH], approximate=True)
    xb = u[..., LRU_WIDTH:]
    xp = jnp.pad(xb, ((0, 0), (CONV_WIDTH - 1, 0), (0, 0)))
    xc = conv_b
    for tap in range(CONV_WIDTH):
        xc = xc + xp[:, tap:tap + S] * conv_w[tap]
    xh = xc.reshape(B, S, LRU_BLOCKS, LRU_BLOCK_DIM)
    r = jax.nn.sigmoid(jnp.einsum('bsnd,nde->bsne', xh, gate_r_w).reshape(B, S, LRU_WIDTH) + gate_r_b)
    ig = jax.nn.sigmoid(jnp.einsum('bsnd,nde->bsne', xh, gate_i_w).reshape(B, S, LRU_WIDTH) + gate_i_b)
    log_a = -RGLRU_C * r.astype(jnp.float32) * jax.nn.softplus(-a_param.astype(jnp.float32))
    a = jnp.exp(log_a)
    mult = jnp.sqrt(-jnp.expm1(2.0 * log_a))
    b = mult * (ig * xc).astype(jnp.float32)
    _, hs = lax.associative_scan(_lin_rec_combine, (a, b), axis=1)
    return (hs.astype(h.dtype) * y) @ w_out


def dilated_branch(q, k, v, window, dilation):
    B, S, H, hd = q.shape
    blk = window // dilation
    span = blk * dilation
    Sp = -(-S // span) * span
    pad = Sp - S
    nb = Sp // span

    def blocks(t):
        return jnp.pad(t, ((0, 0), (0, pad), (0, 0), (0, 0))).reshape(B, nb, blk, dilation, H, t.shape[-1])

    qb, kb, vb = blocks(q), blocks(k), blocks(v)
    kk = jnp.concatenate([jnp.concatenate([jnp.zeros_like(kb[:, :1]), kb[:, :-1]], axis=1), kb], axis=2)
    vv = jnp.concatenate([jnp.concatenate([jnp.zeros_like(vb[:, :1]), vb[:, :-1]], axis=1), vb], axis=2)
    i = np.arange(blk)[:, None]
    j = np.arange(2 * blk)[None, :]
    band = (j >= i) & (j <= i + blk)
    mask = band[None] & ((np.arange(nb)[:, None, None] > 0) | (j >= blk)[None])
    mask = jnp.asarray(mask)[None, :, :, None, None, :]
    s = jnp.einsum('bnqrhd,bnkrhd->bnqrhk', qb, kk).astype(jnp.float32)
    s = jnp.where(mask, s, -jnp.inf)
    m = jnp.max(s, axis=-1, keepdims=True)
    pe = jnp.exp(s - m)
    l = jnp.sum(pe, axis=-1, keepdims=True)
    o = jnp.einsum('bnqrhk,bnkrhd->bnqrhd', pe, vv.astype(jnp.float32))

    def unblock(t):
        return t.reshape(B, Sp, H, t.shape[-1])[:, :S]

    return unblock(o), unblock(m), unblock(l)


def dilated_attention(h, positions, w_qkv, w_out):
    B, S, _ = h.shape
    u = (h @ w_qkv).reshape(B, S, 3, N_HEADS, HEAD_DIM)
    q = rope(u[:, :, 0], positions) * (HEAD_DIM ** -0.5)
    k = rope(u[:, :, 1], positions)
    v = u[:, :, 2]
    outs = [dilated_branch(q, k, v, w, d) for (w, d) in DIL_PATTERNS]
    os_ = jnp.stack([o for (o, _, _) in outs])
    ms = jnp.stack([m for (_, m, _) in outs])
    ls = jnp.stack([l for (_, _, l) in outs])
    wgt = jnp.exp(ms - jnp.max(ms, axis=0, keepdims=True))
    out = jnp.sum(os_ * wgt, axis=0) / jnp.sum(ls * wgt, axis=0)
    return out.astype(h.dtype).reshape(B, S, D_MODEL) @ w_out


def stick_breaking_attention(h, w_qkv, w_out):
    B, S, _ = h.shape
    u = (h @ w_qkv).reshape(B, S, 3, N_HEADS, HEAD_DIM)
    q = u[:, :, 0] * (HEAD_DIM ** -0.5)
    k, v = u[:, :, 1], u[:, :, 2]
    kpos = jnp.arange(S)

    def one_block(args):
        qblk, start = args
        z = jnp.einsum('bqhd,bkhd->bhqk', qblk, k).astype(jnp.float32)
        qpos = start + jnp.arange(Q_BLOCK)
        mask = kpos[None, :] < qpos[:, None]
        lneg = jnp.where(mask, jax.nn.log_sigmoid(-z), 0.0)
        rest = lax.cumsum(lneg, axis=3, reverse=True) - lneg
        att = jnp.where(mask, jnp.exp(jax.nn.log_sigmoid(z) + rest), 0.0)
        return jnp.einsum('bhqk,bkhd->bqhd', att.astype(v.dtype), v)

    starts = jnp.arange(S // Q_BLOCK) * Q_BLOCK
    o = from_blocks(lax.map(one_block, (to_blocks(q), starts)))
    return o.reshape(B, S, D_MODEL) @ w_out


def differential_attention(h, positions, w_qkv, lq1, lk1, lq2, lk2, subln, w_out, layer_idx):
    B, S, _ = h.shape
    u = h @ w_qkv
    q = rope(u[..., :D_MODEL].reshape(B, S, 2 * DIFF_HEADS, HEAD_DIM), positions) * (HEAD_DIM ** -0.5)
    k = rope(u[..., D_MODEL:2 * D_MODEL].reshape(B, S, 2 * DIFF_HEADS, HEAD_DIM), positions)
    v = u[..., 2 * D_MODEL:].reshape(B, S, DIFF_HEADS, 2 * HEAD_DIM)
    lam_init = 0.8 - 0.6 * math.exp(-0.3 * layer_idx)
    lam = (jnp.exp(jnp.sum(lq1.astype(jnp.float32) * lk1.astype(jnp.float32)))
           - jnp.exp(jnp.sum(lq2.astype(jnp.float32) * lk2.astype(jnp.float32))) + lam_init)
    kpos = jnp.arange(S)

    def one_block(args):
        qblk, start = args
        s = jnp.einsum('bqhd,bkhd->bhqk', qblk, k).astype(jnp.float32)
        qpos = start + jnp.arange(Q_BLOCK)
        mask = kpos[None, :] <= qpos[:, None]
        a = jax.nn.softmax(jnp.where(mask, s, -jnp.inf), axis=-1)
        a = a.reshape(B, DIFF_HEADS, 2, Q_BLOCK, S)
        wmap = a[:, :, 0] - lam * a[:, :, 1]
        return jnp.einsum('bhqk,bkhe->bqhe', wmap.astype(v.dtype), v)

    starts = jnp.arange(S // Q_BLOCK) * Q_BLOCK
    o = from_blocks(lax.map(one_block, (to_blocks(q), starts)))
    o = rmsnorm(o, subln, eps=DIFF_SUBLN_EPS) * (1.0 - lam_init)
    return o.reshape(B, S, D_MODEL) @ w_out


def swiglu(h, w_in, w_out):
    u = h @ w_in
    return (jax.nn.silu(u[..., :FFN_HIDDEN]) * u[..., FFN_HIDDEN:]) @ w_out


def setup_inputs(seed: int = 0) -> dict:
    key = jax.random.key(seed)
    ks = iter(jax.random.split(key, 48))

    def dense(shape, fan_in):
        return jax.random.normal(next(ks), shape, jnp.float32) * (fan_in ** -0.5)

    def gain(shape):
        return 1.0 + 0.05 * jax.random.normal(next(ks), shape, jnp.float32)

    def bias(shape):
        return 0.01 * jax.random.normal(next(ks), shape, jnp.float32)

    x = jax.random.normal(next(ks), (BATCH, SEQ, D_MODEL), jnp.float32)
    p = jax.random.normal(next(ks), (DEPTH, BATCH, SEQ, PLE_DIM), jnp.float32)
    offsets = jax.random.randint(next(ks), (BATCH, 1), 0, 4096, dtype=jnp.int32)
    positions = (offsets + jnp.arange(SEQ, dtype=jnp.int32)[None, :]).astype(jnp.int32)

    ln_mix_pre = gain((DEPTH, D_MODEL))
    ln_mix_post = gain((DEPTH, D_MODEL))
    ln_ffn_pre = gain((DEPTH, D_MODEL))
    ln_ffn_post = gain((DEPTH, D_MODEL))
    ln_ple = gain((DEPTH, D_MODEL))
    w_ffn_in = dense((DEPTH, D_MODEL, 2 * FFN_HIDDEN), D_MODEL)
    w_ffn_out = dense((DEPTH, FFN_HIDDEN, D_MODEL), FFN_HIDDEN)
    w_ple_gate = dense((DEPTH, D_MODEL, D_MODEL), D_MODEL)
    b_ple_gate = bias((DEPTH, D_MODEL))
    w_ple_proj = dense((DEPTH, PLE_DIM, D_MODEL), PLE_DIM)

    a_w_in = dense((N_A, D_MODEL, 2 * LRU_WIDTH), D_MODEL)
    a_conv_w = dense((N_A, CONV_WIDTH, LRU_WIDTH), CONV_WIDTH)
    a_conv_b = bias((N_A, LRU_WIDTH))
    a_gate_r_w = dense((N_A, LRU_BLOCKS, LRU_BLOCK_DIM, LRU_BLOCK_DIM), LRU_BLOCK_DIM)
    a_gate_r_b = bias((N_A, LRU_WIDTH))
    a_gate_i_w = dense((N_A, LRU_BLOCKS, LRU_BLOCK_DIM, LRU_BLOCK_DIM), LRU_BLOCK_DIM)
    a_gate_i_b = bias((N_A, LRU_WIDTH))
    a_pow = jax.random.uniform(next(ks), (N_A, LRU_WIDTH), jnp.float32, minval=0.9, maxval=0.999)
    a_base = a_pow ** (1.0 / RGLRU_C)
    a_lambda = jnp.log(a_base) - jnp.log1p(-a_base)
    a_w_out = dense((N_A, LRU_WIDTH, D_MODEL), LRU_WIDTH)

    b_w_qkv = dense((N_B, D_MODEL, 3 * D_MODEL), D_MODEL)
    b_w_out = dense((N_B, D_MODEL, D_MODEL), D_MODEL)

    c_w_qkv = dense((N_C, D_MODEL, 3 * D_MODEL), D_MODEL)
    c_w_out = dense((N_C, D_MODEL, D_MODEL), D_MODEL)

    d_w_qkv = dense((N_D, D_MODEL, 3 * D_MODEL), D_MODEL)
    d_lambda_q1 = 0.1 * jax.random.normal(next(ks), (N_D, HEAD_DIM), jnp.float32)
    d_lambda_k1 = 0.1 * jax.random.normal(next(ks), (N_D, HEAD_DIM), jnp.float32)
    d_lambda_q2 = 0.1 * jax.random.normal(next(ks), (N_D, HEAD_DIM), jnp.float32)
    d_lambda_k2 = 0.1 * jax.random.normal(next(ks), (N_D, HEAD_DIM), jnp.float32)
    d_subln = gain((N_D, 2 * HEAD_DIM))
    d_w_out = dense((N_D, D_MODEL, D_MODEL), D_MODEL)

    return {'x': x, 'p': p, 'positions': positions,
            'ln_mix_pre': ln_mix_pre, 'ln_mix_post': ln_mix_post,
            'ln_ffn_pre': ln_ffn_pre, 'ln_ffn_post': ln_ffn_post, 'ln_ple': ln_ple,
            'w_ffn_in': w_ffn_in, 'w_ffn_out': w_ffn_out,
            'w_ple_gate': w_ple_gate, 'b_ple_gate': b_ple_gate, 'w_ple_proj': w_ple_proj,
            'a_w_in': a_w_in, 'a_conv_w': a_conv_w, 'a_conv_b': a_conv_b,
            'a_gate_r_w': a_gate_r_w, 'a_gate_r_b': a_gate_r_b,
            'a_gate_i_w': a_gate_i_w, 'a_gate_i_b': a_gate_i_b,
            'a_lambda': a_lambda, 'a_w_out': a_w_out,
            'b_w_qkv': b_w_qkv, 'b_w_out': b_w_out,
            'c_w_qkv': c_w_qkv, 'c_w_out': c_w_out,
            'd_w_qkv': d_w_qkv, 'd_lambda_q1': d_lambda_q1, 'd_lambda_k1': d_lambda_k1,
            'd_lambda_q2': d_lambda_q2, 'd_lambda_k2': d_lambda_k2,
            'd_subln': d_subln, 'd_w_out': d_w_out}


def reference(x, p, positions, ln_mix_pre, ln_mix_post, ln_ffn_pre, ln_ffn_post, ln_ple,
              w_ffn_in, w_ffn_out, w_ple_gate, b_ple_gate, w_ple_proj,
              a_w_in, a_conv_w, a_conv_b, a_gate_r_w, a_gate_r_b, a_gate_i_w, a_gate_i_b,
              a_lambda, a_w_out, b_w_qkv, b_w_out, c_w_qkv, c_w_out,
              d_w_qkv, d_lambda_q1, d_lambda_k1, d_lambda_q2, d_lambda_k2, d_subln, d_w_out):
    for i in range(DEPTH):
        kind = i % N_MIXERS
        j = i // N_MIXERS
        h = rmsnorm(x, ln_mix_pre[i])
        if kind == 0:
            y = rglru_block(h, a_w_in[j], a_conv_w[j], a_conv_b[j], a_gate_r_w[j], a_gate_r_b[j],
                            a_gate_i_w[j], a_gate_i_b[j], a_lambda[j], a_w_out[j])
        elif kind == 1:
            y = dilated_attention(h, positions, b_w_qkv[j], b_w_out[j])
        elif kind == 2:
            y = stick_breaking_attention(h, c_w_qkv[j], c_w_out[j])
        else:
            y = differential_attention(h, positions, d_w_qkv[j], d_lambda_q1[j], d_lambda_k1[j],
                                       d_lambda_q2[j], d_lambda_k2[j], d_subln[j], d_w_out[j], i)
        x = x + rmsnorm(y, ln_mix_post[i])
        h = rmsnorm(x, ln_ffn_pre[i])
        x = x + rmsnorm(swiglu(h, w_ffn_in[i], w_ffn_out[i]), ln_ffn_post[i])
        gate = jax.nn.sigmoid(x @ w_ple_gate[i] + b_ple_gate[i])
        x = x + rmsnorm(gate * (p[i] @ w_ple_proj[i]), ln_ple[i])
    return x
```

```cpp
#include <hip/hip_runtime.h>
#include <cstdio>
#include <cstdint>
namespace pg8 {
#define PG8_LAS __attribute__((address_space(3)))
typedef unsigned short bf16_t;
typedef short bf16x8 __attribute__((ext_vector_type(8)));
typedef float f32x4 __attribute__((ext_vector_type(4)));
typedef unsigned u32x4 __attribute__((ext_vector_type(4)));
constexpr int BM = 256, BK = 64, HALF = 128, HTB = HALF * BK * 2  , STAGE_BYTES = 8 * HTB, NXCD = 8, WGM = 8;

__host__ __device__ __forceinline__ int lds_byte(int r, int c) { const int st = (r >> 4) * 2 + (c >> 5), rr = r & 15, cc = c & 31, ob = rr * 64 + cc * 2; return st * 1024 + (ob ^ (((ob >> 9) & 1) << 5)); }
__host__ __device__ __forceinline__ void stage_rc(int b, int& R, int& C) { const int st = b / 1024, sb = b % 1024, swz = sb ^ (((sb >> 9) & 1) << 5); R = (st >> 1) * 16 + swz / 64; C = (st & 1) * 32 + (swz % 64) / 2; }
__host__ __device__ __forceinline__ int perm32(int rho) { const int n = rho >> 4, i = rho & 15; return 8 * (i >> 2) + 4 * n + (i & 3); }

struct Unit { int pm, pn; };
struct Gemm { const bf16_t* A; const bf16_t* Bt; int M, N, K; };

struct StaticOrder {
    int nM, nN, nwg, G, c;
    __host__ __device__ void init(int M, int N, int G_, int c_) { nM = M / BM; nN = N / BM; nwg = nM * nN; G = G_; c = c_; }
    __host__ __device__ bool next(int i, Unit& u) const {
        const long L = (long)i * G + c; if (L >= nwg) return false;
        int wgid = (int)L; { const int q = nwg / NXCD, r = nwg % NXCD, xcd = wgid % NXCD, off = wgid / NXCD; wgid = (xcd < r ? xcd * (q + 1) : r * (q + 1) + (xcd - r) * q) + off; }
        const int nig = WGM * nN, gid = wgid / nig, fm = gid * WGM, gsz = (nM - fm) < WGM ? (nM - fm) : WGM;
        u.pm = fm + ((wgid % nig) % gsz); u.pn = (wgid % nig) / gsz; return true;
    }
    __device__ __forceinline__ void a_ready(const Unit&) const {}
    __device__ __forceinline__ void done(const Unit&) const {}
};

__device__ __forceinline__ unsigned cvt_pk_bf16(float lo, float hi) { unsigned r; asm volatile("v_cvt_pk_bf16_f32 %0, %1, %2" : "=v"(r) : "v"(lo), "v"(hi)); return r; }
typedef float f32x2 __attribute__((ext_vector_type(2)));
__device__ __forceinline__ f32x2 gelu_pk(f32x2 v) {
    const f32x2 av = __builtin_elementwise_abs(v), d = av * 0.2316418882f + 1.0f;
    f32x2 t; t.x = __builtin_amdgcn_rcpf(d.x); t.y = __builtin_amdgcn_rcpf(d.y);
    f32x2 q = t * 0.5307027145f + (-0.7265760135f); q = q * t + 0.7107068705f; q = q * t + (-0.142248368f); q = q * t + 0.127414796f; q = q * t;
    const f32x2 s = (v * v) * (-0.72134752044f);
    f32x2 e; e.x = __builtin_amdgcn_exp2f(s.x); e.y = __builtin_amdgcn_exp2f(s.y);
    const f32x2 m = v * (q * e), r = v - m;
    f32x2 o; o.x = v.x < 0.f ? m.x : r.x; o.y = v.y < 0.f ? m.y : r.y; return o;
}

template <int ACT  > struct EpiBf16 {
    static constexpr bool PERM = true, AFTER_DRAIN = false; static_assert(ACT == 0 || ACT == 1, "EpiBf16: ACT is 0 (none) or 1 (gelu_pk)");
    bf16_t* O; int ldc; const float* bias; int split_cols; size_t split_stride; float scale0;
    __device__ __forceinline__ void operator()(const f32x4 (&acc)[2][2][4][2], const Unit& u, int wr, int wc, int fr, int fq) const {
        const int row0 = u.pm * BM + wr * 64 + fr; int colt = u.pn * BM; bf16_t* base = O;
        float sc = 1.f; if (split_cols) { const int t = colt / split_cols; base += (size_t)t * split_stride; colt -= t * split_cols; if (t == 0) sc = scale0; }
        const int col0 = colt + wc * 32 + 8 * fq, bcol0 = u.pn * BM + wc * 32 + 8 * fq;
        f32x4 bv[2][2];
#pragma unroll
        for (int bj = 0; bj < 2; ++bj)
#pragma unroll
            for (int n = 0; n < 2; ++n) bv[bj][n] = bias ? *(const f32x4*)(bias + bcol0 + bj * HALF + 4 * n) : (f32x4){0.f, 0.f, 0.f, 0.f};
#pragma unroll
        for (int ai = 0; ai < 2; ++ai)
#pragma unroll
            for (int m = 0; m < 4; ++m) { bf16_t* rowp = base + (size_t)(row0 + ai * HALF + m * 16) * ldc + col0;
#pragma unroll
                for (int bj = 0; bj < 2; ++bj) { f32x4 v0 = acc[ai][bj][m][0] + bv[bj][0], v1 = acc[ai][bj][m][1] + bv[bj][1];
                    if (ACT == 1) { f32x2 a = gelu_pk((f32x2){v0[0], v0[1]}), b = gelu_pk((f32x2){v0[2], v0[3]}), c = gelu_pk((f32x2){v1[0], v1[1]}), d = gelu_pk((f32x2){v1[2], v1[3]});
                        v0 = (f32x4){a.x, a.y, b.x, b.y}; v1 = (f32x4){c.x, c.y, d.x, d.y}; }
                    v0 = v0 * sc; v1 = v1 * sc; u32x4 w; w.x = cvt_pk_bf16(v0[0], v0[1]); w.y = cvt_pk_bf16(v0[2], v0[3]); w.z = cvt_pk_bf16(v1[0], v1[1]); w.w = cvt_pk_bf16(v1[2], v1[3]);
                    *(u32x4*)(rowp + bj * HALF) = w; } }
    }
};

struct PanelStats {
    unsigned* xbuf;
    unsigned* cnt;
    unsigned* tmo;
    int ntn; float eps;
    unsigned code;
    __device__ __forceinline__ bool run(const f32x4 (&v)[2][2][4][2], const Unit& u, int wr, int wc, int fr, int fq, PG8_LAS unsigned char* lds, int wid, int lane) const {
        typedef float f32x2v __attribute__((ext_vector_type(2)));
        PG8_LAS f32x2v* P = (PG8_LAS f32x2v*)lds;
        PG8_LAS f32x2v* S = (PG8_LAS f32x2v*)(lds + 8192);
        PG8_LAS unsigned* flag = (PG8_LAS unsigned*)(lds + 8192 + 2048);
#pragma unroll
        for (int ai = 0; ai < 2; ++ai)
#pragma unroll
            for (int m = 0; m < 4; ++m) {
                float s = 0.f;
#pragma unroll
                for (int bj = 0; bj < 2; ++bj)
#pragma unroll
                    for (int n = 0; n < 2; ++n) { const f32x4 x = v[ai][bj][m][n]; s += (x[0] + x[1]) + (x[2] + x[3]); }
                s += __shfl_xor(s, 16); s += __shfl_xor(s, 32);
                const float mw = s * (1.0f / 64.0f); float q = 0.f;
#pragma unroll
                for (int bj = 0; bj < 2; ++bj)
#pragma unroll
                    for (int n = 0; n < 2; ++n) { const f32x4 d = v[ai][bj][m][n] - mw; q += (d[0] * d[0] + d[1] * d[1]) + (d[2] * d[2] + d[3] * d[3]); }
                q += __shfl_xor(q, 16); q += __shfl_xor(q, 32);
                if (fq == 0) P[(ai * HALF + wr * 64 + m * 16 + fr) * 4 + wc] = (f32x2v){mw, q};
            }
        asm volatile("s_waitcnt lgkmcnt(0)" ::: "memory"); __builtin_amdgcn_s_barrier(); asm volatile("" ::: "memory");
#if defined(BROKEN_EXCHANGE_NO_WAIT)
#warning BROKEN CONTROL BUILD: the row-statistics exchange does not wait; results are wrong by design
        if (blockIdx.x >= 64) { const long long t0_ = clock64(); while (clock64() - t0_ < 60000) __builtin_amdgcn_s_sleep(8); }
#endif
        const int row = wid * 32 + (lane & 31);
        if (lane < 32) {
            const f32x2v a = P[row * 4 + 0], b = P[row * 4 + 1], c = P[row * 4 + 2], d = P[row * 4 + 3];
            const float mt = (a.x + b.x + c.x + d.x) * 0.25f;
            const float da = a.x - mt, db = b.x - mt, dc = c.x - mt, dd = d.x - mt;
            const float m2 = (a.y + b.y) + (c.y + d.y) + 64.0f * ((da * da + db * db) + (dc * dc + dd * dd));
            unsigned long long* slot = (unsigned long long*)xbuf + ((size_t)(u.pm * BM + row) * 4 + u.pn);
            __hip_atomic_store(slot, ((unsigned long long)__float_as_uint(m2) << 32) | __float_as_uint(mt), __ATOMIC_RELAXED, __HIP_MEMORY_SCOPE_AGENT);
        }
        asm volatile("s_waitcnt vmcnt(0)" ::: "memory");
        if (lane == 0) __hip_atomic_fetch_add(cnt + 64 * u.pm, 1u, __ATOMIC_RELAXED, __HIP_MEMORY_SCOPE_AGENT);
        if (wid == 0) {
            bool dead = false; const unsigned long long t0 = __builtin_amdgcn_s_memrealtime(); const unsigned want = 8u * (unsigned)ntn;
            for (;;) {
#if defined(BROKEN_EXCHANGE_NO_WAIT)
                break;
#endif
                if ((unsigned)__builtin_amdgcn_readfirstlane(__hip_atomic_load(cnt + 64 * u.pm, __ATOMIC_RELAXED, __HIP_MEMORY_SCOPE_AGENT)) >= want) break;
                if (__builtin_amdgcn_s_memrealtime() - t0 > 2000000ull) {
                    if (lane == 0) { unsigned expect = 0u; __hip_atomic_compare_exchange_strong(tmo + 1, &expect, code | (unsigned)(u.pm & 0xff), __ATOMIC_RELAXED, __ATOMIC_RELAXED, __HIP_MEMORY_SCOPE_AGENT);
                                     __hip_atomic_store(tmo, 1u, __ATOMIC_RELAXED, __HIP_MEMORY_SCOPE_AGENT); }
                    dead = true; break; }
                __builtin_amdgcn_s_sleep(2);
            }
            __builtin_amdgcn_fence(__ATOMIC_ACQUIRE, "agent");
            if (lane == 0) flag[0] = dead ? 1u : 0u;
        }
        asm volatile("s_waitcnt vmcnt(0) lgkmcnt(0)" ::: "memory"); __builtin_amdgcn_s_barrier(); asm volatile("" ::: "memory");
        const bool bad = flag[0] != 0u;
        if (lane < 32) {
            const unsigned long long* slot = (const unsigned long long*)xbuf + (size_t)(u.pm * BM + row) * 4; float mt[4], m2[4]; float ms = 0.f;
#pragma unroll
            for (int t = 0; t < 4; ++t) { if (t < ntn) { const unsigned long long w = __hip_atomic_load(slot + t, __ATOMIC_RELAXED, __HIP_MEMORY_SCOPE_AGENT); mt[t] = __uint_as_float((unsigned)w); m2[t] = __uint_as_float((unsigned)(w >> 32)); } else { mt[t] = 0.f; m2[t] = 0.f; } ms += mt[t]; }
            const float mean = ms / (float)ntn; float q = 0.f;
#pragma unroll
            for (int t = 0; t < 4; ++t) if (t < ntn) { const float dm = mt[t] - mean; q += m2[t] + 256.0f * dm * dm; }
            S[row] = (f32x2v){mean, 1.0f / sqrtf(q / (256.0f * (float)ntn) + eps)};
        }
        asm volatile("s_waitcnt lgkmcnt(0)" ::: "memory"); __builtin_amdgcn_s_barrier(); asm volatile("" ::: "memory");
        return bad;
    }
};
struct EpiLnRes {
    static constexpr bool PERM = false, AFTER_DRAIN = true;
    const float* base; float* out; int ldc; const float* bias; PanelStats st; unsigned poison;
    __device__ __forceinline__ void fused(f32x4 (&acc)[2][2][4][2], const Unit& u, int wr, int wc, int fr, int fq, PG8_LAS unsigned char* lds, int wid, int lane) const {
        typedef float f32x2v __attribute__((ext_vector_type(2)));
        const PG8_LAS f32x2v* S = (const PG8_LAS f32x2v*)(lds + 8192);
        const int col0 = u.pn * BM + wc * 32 + 4 * fq;
#pragma unroll
        for (int bj = 0; bj < 2; ++bj)
#pragma unroll
            for (int n = 0; n < 2; ++n) { const f32x4 bv = bias ? *(const f32x4*)(bias + col0 + bj * HALF + n * 16) : (f32x4){0.f, 0.f, 0.f, 0.f};
#pragma unroll
                for (int ai = 0; ai < 2; ++ai)
#pragma unroll
                    for (int m = 0; m < 4; ++m) acc[ai][bj][m][n] += bv; }
        f32x4 pre[4][2][2];
#pragma unroll
        for (int m = 0; m < 4; ++m) { const size_t off = (size_t)(u.pm * BM + wr * 64 + m * 16 + fr) * ldc + col0;
#pragma unroll
            for (int bj = 0; bj < 2; ++bj)
#pragma unroll
                for (int n = 0; n < 2; ++n) pre[m][bj][n] = *(const f32x4*)(base + off + bj * HALF + n * 16); }
        const bool bad = st.run(acc, u, wr, wc, fr, fq, lds, wid, lane) || poison != 0u;
        const float qnan = __builtin_nanf("");
#pragma unroll
        for (int ai = 0; ai < 2; ++ai)
#pragma unroll
            for (int m = 0; m < 4; ++m) { const int r = ai * HALF + wr * 64 + m * 16 + fr; const f32x2v sr = S[r]; const size_t off = (size_t)(u.pm * BM + r) * ldc + col0;
#pragma unroll
                for (int bj = 0; bj < 2; ++bj)
#pragma unroll
                    for (int n = 0; n < 2; ++n) { const f32x4 bs = ai == 0 ? pre[m][bj][n] : *(const f32x4*)(base + off + bj * HALF + n * 16); f32x4 o = bs + (acc[ai][bj][m][n] - sr.x) * sr.y;
                        if (bad) o = (f32x4){qnan, qnan, qnan, qnan}; *(f32x4*)(out + off + bj * HALF + n * 16) = o; }
                if (m & 1) asm volatile("" ::: "memory"); }
    }
};
struct EpiLnResLn {
    static constexpr bool PERM = false, AFTER_DRAIN = true;
    const float* base; float* out; bf16_t* xn; int ldc; const float* bias; PanelStats st1, st2; unsigned poison;
    __device__ __forceinline__ void fused(f32x4 (&acc)[2][2][4][2], const Unit& u, int wr, int wc, int fr, int fq, PG8_LAS unsigned char* lds, int wid, int lane) const {
        typedef float f32x2v __attribute__((ext_vector_type(2))); typedef unsigned u32x2v __attribute__((ext_vector_type(2)));
        const PG8_LAS f32x2v* S = (const PG8_LAS f32x2v*)(lds + 8192);
        const int col0 = u.pn * BM + wc * 32 + 4 * fq;
#pragma unroll
        for (int bj = 0; bj < 2; ++bj)
#pragma unroll
            for (int n = 0; n < 2; ++n) { const f32x4 bv = bias ? *(const f32x4*)(bias + col0 + bj * HALF + n * 16) : (f32x4){0.f, 0.f, 0.f, 0.f};
#pragma unroll
                for (int ai = 0; ai < 2; ++ai)
#pragma unroll
                    for (int m = 0; m < 4; ++m) acc[ai][bj][m][n] += bv; }
        bool bad = st1.run(acc, u, wr, wc, fr, fq, lds, wid, lane) || poison != 0u;
        const float qnan = __builtin_nanf("");
#pragma unroll
        for (int ai = 0; ai < 2; ++ai)
#pragma unroll
            for (int m = 0; m < 4; ++m) { const int r = ai * HALF + wr * 64 + m * 16 + fr; const f32x2v sr = S[r]; const size_t off = (size_t)(u.pm * BM + r) * ldc + col0;
#pragma unroll
                for (int bj = 0; bj < 2; ++bj)
#pragma unroll
                    for (int n = 0; n < 2; ++n) { const f32x4 bs = *(const f32x4*)(base + off + bj * HALF + n * 16); acc[ai][bj][m][n] = bs + (acc[ai][bj][m][n] - sr.x) * sr.y; }
                asm volatile("" : "+v"(acc[ai][0][m][0]), "+v"(acc[ai][0][m][1]), "+v"(acc[ai][1][m][0]), "+v"(acc[ai][1][m][1]));
                if (m & 1) asm volatile("" ::: "memory"); }
        const bool bad1 = bad;
        bad = st2.run(acc, u, wr, wc, fr, fq, lds, wid, lane) || bad;
#pragma unroll
        for (int ai = 0; ai < 2; ++ai)
#pragma unroll
            for (int m = 0; m < 4; ++m) { const int r = ai * HALF + wr * 64 + m * 16 + fr; const f32x2v sr = S[r]; const size_t off = (size_t)(u.pm * BM + r) * ldc + col0;
#pragma unroll
                for (int bj = 0; bj < 2; ++bj)
#pragma unroll
                    for (int n = 0; n < 2; ++n) { const f32x4 x1 = acc[ai][bj][m][n]; *(f32x4*)(out + off + bj * HALF + n * 16) = bad1 ? (f32x4){qnan, qnan, qnan, qnan} : x1;
                        const f32x4 o = (x1 - sr.x) * sr.y; u32x2v w; w.x = cvt_pk_bf16(o[0], o[1]); w.y = cvt_pk_bf16(o[2], o[3]);
                        if (bad) { w.x = 0x7fc07fc0u; w.y = 0x7fc07fc0u; } *(u32x2v*)(xn + off + bj * HALF + n * 16) = w; }
                asm volatile("" ::: "memory"); }
    }
};

template <class Epi, class Sched, bool ALIGN_EPI = false, bool SP2 = false>
__device__ __forceinline__ void gemm_phase(PG8_LAS unsigned char* lds, const Gemm g, const Sched& S, const Epi& E) {
    int tid_ = threadIdx.x; asm volatile("" : "+v"(tid_));
    const int tid = tid_, wid = __builtin_amdgcn_readfirstlane(tid >> 6), lane = tid & 63, wr = wid >> 2, wc = wid & 3, fr = lane & 15, fq = lane >> 4;
    const int K = g.K, nt = K / BK;
    unsigned voffA[2], voffB[2];
#pragma unroll
    for (int i = 0; i < 2; ++i) { int R, C; stage_rc(tid * 16 + i * 8192, R, C); const int Rb = Epi::PERM ? ((R & ~31) + perm32(R & 31)) : R;
        voffA[i] = (unsigned)(R * K + C) * 2u; voffB[i] = (unsigned)(Rb * K + C) * 2u; }
    const size_t kstep = (size_t)(BK * 2);
    const size_t hstep = (size_t)HALF * K * 2;
    const size_t tstep = 2 * hstep;
    const unsigned ldsw = (unsigned)wid * 1024u;
    const int aoff = lds_byte(wr * 64 + fr, fq * 8), boff = lds_byte(wc * 32 + fr, fq * 8);
#define PG8_SA(b, h) (((b) * 2 + (h)) * HTB)
#define PG8_SB(b, h) ((4 + (b) * 2 + (h)) * HTB)
#define PG8_STAGE(bufoff, gbase, voff) do { _Pragma("unroll") for (int _i = 0; _i < 2; ++_i) \
        __builtin_amdgcn_global_load_lds((const unsigned*)((const char*)(gbase) + (voff)[_i]), (PG8_LAS unsigned*)(lds + (bufoff) + ldsw + _i * 8192), 16, 0, 0); } while (0)
#define PG8_LDA(dst, b, h) do { _Pragma("unroll") for (int m = 0; m < 4; ++m) _Pragma("unroll") for (int k = 0; k < 2; ++k) dst[m][k] = *(const PG8_LAS bf16x8*)(lds + PG8_SA(b, h) + aoff + m * 2048 + k * 1024); } while (0)
#define PG8_LDB(dst, b, h) do { _Pragma("unroll") for (int n = 0; n < 2; ++n) _Pragma("unroll") for (int k = 0; k < 2; ++k) dst[n][k] = *(const PG8_LAS bf16x8*)(lds + PG8_SB(b, h) + boff + n * 2048 + k * 1024); } while (0)
#define PG8_MMA(ai, bj, At, Bt) do { __builtin_amdgcn_s_setprio(1); _Pragma("unroll") for (int m = 0; m < 4; ++m) _Pragma("unroll") for (int n = 0; n < 2; ++n) _Pragma("unroll") for (int k = 0; k < 2; ++k) \
        acc[ai][bj][m][n] = __builtin_amdgcn_mfma_f32_16x16x32_bf16(Bt[n][k], At[m][k], acc[ai][bj][m][n], 0, 0, 0); __builtin_amdgcn_s_setprio(0); } while (0)
#define PG8_WAIT_V(n) asm volatile("s_waitcnt vmcnt(" #n ")" ::: "memory")
#define PG8_WAIT_L(n) asm volatile("s_waitcnt lgkmcnt(" #n ")" ::: "memory")
#define PG8_BAR __builtin_amdgcn_s_barrier()
#define PG8_SCHED __builtin_amdgcn_sched_barrier(0)
    Unit cur, nxt; int ui = 0;
    if (!S.next(0, cur)) return;
    f32x4 acc[2][2][4][2];
#pragma unroll
    for (int a = 0; a < 2; ++a)
#pragma unroll
        for (int b = 0; b < 2; ++b)
#pragma unroll
            for (int m = 0; m < 4; ++m)
#pragma unroll
                for (int n = 0; n < 2; ++n) acc[a][b][m][n] = (f32x4){0.f, 0.f, 0.f, 0.f};
    bf16x8 At[4][2], B0[2][2], B1[2][2];
    const char* cA = (const char*)g.A + (size_t)cur.pm * tstep; const char* cB = (const char*)g.Bt + (size_t)cur.pn * tstep;
    S.a_ready(cur);
    if constexpr (SP2) {
        PG8_STAGE(PG8_SB(0, 0), cB, voffB); PG8_STAGE(PG8_SB(0, 1), cB + hstep, voffB); PG8_STAGE(PG8_SA(0, 0), cA, voffA); PG8_STAGE(PG8_SA(0, 1), cA + hstep, voffA);
        if (wr == 1) PG8_BAR;
        PG8_WAIT_V(2); PG8_BAR;
        PG8_STAGE(PG8_SB(1, 0), cB + kstep, voffB); PG8_STAGE(PG8_SA(1, 0), cA + kstep, voffA); PG8_STAGE(PG8_SB(1, 1), cB + hstep + kstep, voffB);
        PG8_WAIT_V(6); PG8_BAR;
    } else {
        PG8_STAGE(PG8_SB(0, 0), cB, voffB); PG8_STAGE(PG8_SA(0, 0), cA, voffA); PG8_STAGE(PG8_SB(0, 1), cB + hstep, voffB); PG8_STAGE(PG8_SA(0, 1), cA + hstep, voffA);
        if (wr == 1) PG8_BAR;
        PG8_WAIT_V(4); PG8_BAR;
        PG8_STAGE(PG8_SB(1, 0), cB + kstep, voffB); PG8_STAGE(PG8_SA(1, 0), cA + kstep, voffA); PG8_STAGE(PG8_SB(1, 1), cB + hstep + kstep, voffB);
        PG8_WAIT_V(6); PG8_BAR;
    }
    for (;;) {
        const bool has_next = S.next(ui + 1, nxt);
        const char* nA = has_next ? (const char*)g.A + (size_t)nxt.pm * tstep : cA; const char* nB = has_next ? (const char*)g.Bt + (size_t)nxt.pn * tstep : cB;
        for (int t = 0; t < nt; t += 2) {
            const bool last = (t == nt - 2);
            const char* a1 = cA + (size_t)(t + 1) * kstep;
            const char* a2 = last ? nA : cA + (size_t)(t + 2) * kstep; const char* b2 = last ? nB : cB + (size_t)(t + 2) * kstep;
            const char* a3 = a2 + kstep; const char* b3 = b2 + kstep;
            if (last && has_next) S.a_ready(nxt);
            if constexpr (SP2) {
            PG8_LDB(B0, 0, 0); PG8_LDB(B1, 0, 1); PG8_SCHED; PG8_LDA(At, 0, 0); PG8_STAGE(PG8_SA(1, 1), a1 + hstep, voffA);
            PG8_WAIT_V(8); PG8_WAIT_L(0); PG8_BAR; PG8_MMA(0, 0, At, B0); PG8_MMA(0, 1, At, B1); PG8_BAR; PG8_SCHED;
            PG8_LDA(At, 0, 1); PG8_STAGE(PG8_SB(0, 0), b2, voffB); PG8_STAGE(PG8_SB(0, 1), b2 + hstep, voffB); PG8_STAGE(PG8_SA(0, 0), a2, voffA);
            PG8_WAIT_V(8); PG8_WAIT_L(0); PG8_BAR; PG8_MMA(1, 0, At, B0); PG8_MMA(1, 1, At, B1); PG8_BAR; PG8_SCHED;
            PG8_LDB(B0, 1, 0); PG8_LDB(B1, 1, 1); PG8_SCHED; PG8_LDA(At, 1, 0); PG8_STAGE(PG8_SA(0, 1), a2 + hstep, voffA);
            PG8_WAIT_V(8); PG8_WAIT_L(0); PG8_BAR; PG8_MMA(0, 0, At, B0); PG8_MMA(0, 1, At, B1); PG8_BAR; PG8_SCHED;
            PG8_LDA(At, 1, 1); PG8_STAGE(PG8_SB(1, 0), b3, voffB); PG8_STAGE(PG8_SB(1, 1), b3 + hstep, voffB); PG8_STAGE(PG8_SA(1, 0), a3, voffA);
            PG8_WAIT_V(8); PG8_WAIT_L(0); PG8_BAR; PG8_MMA(1, 0, At, B0); PG8_MMA(1, 1, At, B1); PG8_BAR; PG8_SCHED;
            } else {
            PG8_LDB(B0, 0, 0); PG8_SCHED; PG8_LDA(At, 0, 0); PG8_STAGE(PG8_SA(1, 1), a1 + hstep, voffA);
            PG8_WAIT_L(8); PG8_BAR; PG8_WAIT_L(0); PG8_MMA(0, 0, At, B0); PG8_BAR; PG8_SCHED;
            PG8_LDB(B1, 0, 1); PG8_STAGE(PG8_SB(0, 0), b2, voffB);
            PG8_BAR; PG8_WAIT_L(0); PG8_MMA(0, 1, At, B1); PG8_BAR;
            PG8_LDA(At, 0, 1); PG8_STAGE(PG8_SA(0, 0), a2, voffA);
            PG8_BAR; PG8_WAIT_L(0); PG8_MMA(1, 0, At, B0); PG8_BAR; PG8_SCHED;
            PG8_STAGE(PG8_SB(0, 1), b2 + hstep, voffB);
            PG8_WAIT_V(6); PG8_BAR; PG8_MMA(1, 1, At, B1); PG8_BAR;
            PG8_LDB(B0, 1, 0); PG8_SCHED; PG8_LDA(At, 1, 0); PG8_STAGE(PG8_SA(0, 1), a2 + hstep, voffA);
            PG8_WAIT_L(8); PG8_BAR; PG8_WAIT_L(0); PG8_MMA(0, 0, At, B0); PG8_BAR; PG8_SCHED;
            PG8_LDB(B1, 1, 1); PG8_STAGE(PG8_SB(1, 0), b3, voffB);
            PG8_BAR; PG8_WAIT_L(0); PG8_MMA(0, 1, At, B1); PG8_BAR;
            PG8_LDA(At, 1, 1); PG8_STAGE(PG8_SA(1, 0), a3, voffA);
            PG8_BAR; PG8_WAIT_L(0); PG8_MMA(1, 0, At, B0); PG8_BAR; PG8_SCHED;
            PG8_STAGE(PG8_SB(1, 1), b3 + hstep, voffB);
            PG8_WAIT_V(6); PG8_BAR; PG8_MMA(1, 1, At, B1); PG8_BAR;
            }
        }
        if constexpr (ALIGN_EPI) { if (wr == 0) PG8_BAR; }
        if constexpr (!Epi::AFTER_DRAIN) { E(acc, cur, wr, wc, fr, fq); S.done(cur); }
        if (!has_next) break;
#pragma unroll
        for (int a = 0; a < 2; ++a)
#pragma unroll
            for (int b = 0; b < 2; ++b)
#pragma unroll
                for (int m = 0; m < 4; ++m)
#pragma unroll
                    for (int n = 0; n < 2; ++n) acc[a][b][m][n] = (f32x4){0.f, 0.f, 0.f, 0.f};
        cur = nxt; cA = nA; cB = nB; ++ui;
        if constexpr (ALIGN_EPI) { if (wr == 1) PG8_BAR; }
    }
    PG8_WAIT_V(0);
    if constexpr (!ALIGN_EPI) { if (wr == 0) PG8_BAR; }
    PG8_BAR;
    if constexpr (Epi::AFTER_DRAIN) { E.fused(acc, cur, wr, wc, fr, fq, lds, wid, lane); S.done(cur); }
#undef PG8_SA
#undef PG8_SB
#undef PG8_STAGE
#undef PG8_LDA
#undef PG8_LDB
#undef PG8_MMA
#undef PG8_WAIT_V
#undef PG8_WAIT_L
#undef PG8_BAR
#undef PG8_SCHED
}
}

#ifndef PG8_SP2
#define PG8_SP2 true
#endif
#ifndef PG8_ALIGN
#define PG8_ALIGN true
#endif
#include <hip/hip_bf16.h>
#include <cmath>
namespace attn_body {
using bf16=__hip_bfloat16;
using bf16x8=__attribute__((ext_vector_type(8)))short;
using s16x4=__attribute__((ext_vector_type(4)))short;
using f32x16=__attribute__((ext_vector_type(16)))float;
using u32x4=__attribute__((ext_vector_type(4)))unsigned;
constexpr int BATCH=2,NHEAD=16,SEQ=8192,D=64,DM=NHEAD*D;
constexpr int NW=8,QBLK=32,QB=QBLK*NW,KVBLK=64,NQB=SEQ/QB;
constexpr int ATTN_PITCH=DM, ATTN_UNIT_ROWS=QB;
__device__ __forceinline__ int crow(int r,int hi){return (r&3)+8*(r>>2)+4*hi;}
#define SBAR() __builtin_amdgcn_sched_barrier(0)
__device__ __forceinline__ void cmask(f32x16&p0,f32x16&p1,int jb,int qrel,int hi){
  const float NEG=-INFINITY; int kb=64*jb+4*hi;
  #pragma unroll
  for(int r=0;r<16;++r){int kv=kb+(r&3)+8*(r>>2); if(kv>qrel)p0[r]=NEG; if(kv+32>qrel)p1[r]=NEG;}
}

constexpr int NSLOT=3, SLOTB=8192;
constexpr int LDS_K=0, LDS_V=NSLOT*SLOTB, LDS_WS=2*NSLOT*SLOTB, LDS_OST=LDS_WS+NW*64*4, LDS_BYTES=LDS_OST+NW*4096;
constexpr float C2=0.125f*1.4426950408889634f;
__device__ __forceinline__ void glds16(const void*gsrc,unsigned lds_dst){unsigned keep;
  asm volatile("s_mov_b32 %0, m0\n\ts_mov_b32 m0, %2\n\ts_nop 0\n\tglobal_load_lds_dwordx4 %1, off\n\ts_mov_b32 m0, %0":"=&s"(keep):"v"(gsrc),"s"(lds_dst):"memory");}
__device__ __forceinline__ float max3f(float a,float b,float c){float r;asm("v_max3_f32 %0, %1, %2, %3":"=v"(r):"v"(a),"v"(b),"v"(c));return r;}
__device__ __forceinline__ float max2f(float a,float b){float r;asm("v_max_f32_e32 %0, %1, %2":"=v"(r):"v"(a),"v"(b));return r;}
__device__ __forceinline__ float fadd_s(float a,float b){float r;asm("v_add_f32_e32 %0, %1, %2":"=v"(r):"v"(a),"v"(b));return r;}
__device__ __forceinline__ float fsub_s(float a,float b){float r;asm("v_sub_f32_e32 %0, %1, %2":"=v"(r):"v"(a),"v"(b));return r;}
typedef float f32x2_t __attribute__((ext_vector_type(2))); typedef __bf16 bf16x2_t __attribute__((ext_vector_type(2)));
__device__ __forceinline__ unsigned cvtpk_s(float lo,float hi){f32x2_t v={lo,hi};bf16x2_t b=__builtin_convertvector(v,bf16x2_t);return __builtin_bit_cast(unsigned,b);}
#define WAIT_BAR(N) asm volatile("s_waitcnt vmcnt(" #N ") lgkmcnt(0)\n\ts_barrier":::"memory")

__device__ __forceinline__ void qkt(f32x16&p0,f32x16&p1,const char*Kslot,const bf16x8*qr,const f32x16&negm,int r32,int hi){
  const char*kb=Kslot+hi*1024+r32*16;
  #pragma unroll
  for(int d0=0;d0<4;++d0){
    const bf16x8 b0=*reinterpret_cast<const bf16x8*>(kb+d0*2048);
    const bf16x8 b1=*reinterpret_cast<const bf16x8*>(kb+d0*2048+512);
    if(d0==0){p0=__builtin_amdgcn_mfma_f32_32x32x16_bf16(b0,qr[0],negm,0,0,0);p1=__builtin_amdgcn_mfma_f32_32x32x16_bf16(b1,qr[0],negm,0,0,0);}
    else{p0=__builtin_amdgcn_mfma_f32_32x32x16_bf16(b0,qr[d0],p0,0,0,0);p1=__builtin_amdgcn_mfma_f32_32x32x16_bf16(b1,qr[d0],p1,0,0,0);}}
}
typedef __attribute__((address_space(3))) const char* lds_cptr;
typedef short v4i16_t __attribute__((ext_vector_type(4)));
__device__ __forceinline__ void kload8(bf16x8*kf,lds_cptr kp){
  kf[0]=*(const __attribute__((address_space(3))) bf16x8*)(kp);      kf[1]=*(const __attribute__((address_space(3))) bf16x8*)(kp+512);
  kf[2]=*(const __attribute__((address_space(3))) bf16x8*)(kp+2048); kf[3]=*(const __attribute__((address_space(3))) bf16x8*)(kp+2560);
  kf[4]=*(const __attribute__((address_space(3))) bf16x8*)(kp+4096); kf[5]=*(const __attribute__((address_space(3))) bf16x8*)(kp+4608);
  kf[6]=*(const __attribute__((address_space(3))) bf16x8*)(kp+6144); kf[7]=*(const __attribute__((address_space(3))) bf16x8*)(kp+6656);
}
__device__ __forceinline__ void kload2(bf16x8*kf,lds_cptr kp,int j){ kf[2*j]=*(const __attribute__((address_space(3))) bf16x8*)(kp+j*2048); kf[2*j+1]=*(const __attribute__((address_space(3))) bf16x8*)(kp+j*2048+512); }
__device__ __forceinline__ s16x4 vtr(lds_cptr p){ return __builtin_bit_cast(s16x4,__builtin_amdgcn_ds_read_tr16_b64_v4i16((__attribute__((address_space(3))) v4i16_t*)p)); }
__device__ __forceinline__ float rowmax(const f32x16&p0,const f32x16&p1){
  float a=max3f(p0[0],p0[1],p1[0]),b=max3f(p0[2],p0[3],p1[1]);a=max3f(a,p1[2],p1[3]);
  #pragma unroll
  for(int r=4;r<16;r+=4){a=max3f(a,p0[r],p0[r+1]);b=max3f(b,p0[r+2],p0[r+3]);a=max3f(a,p1[r],p1[r+1]);b=max3f(b,p1[r+2],p1[r+3]);}
  const float m=max2f(a,b);
  auto rr=__builtin_amdgcn_permlane32_swap(__float_as_uint(m),__float_as_uint(m),false,false);
  return max2f(__uint_as_float(rr[0]),__uint_as_float(rr[1]));
}
__device__ __forceinline__ void pv(f32x16*o,int vb,bf16x8 pa0,bf16x8 pa1,bf16x8 pa2,bf16x8 pa3){
  #pragma unroll
  for(int d0=0;d0<2;++d0){s16x4 lo[4],hi[4];
    #pragma unroll
    for(int ks=0;ks<4;++ks){
      asm volatile("ds_read_b64_tr_b16 %0,%1 offset:%c2":"=&v"(lo[ks]):"v"(vb),"i"(d0*4096+ks*1024):"memory");
      asm volatile("ds_read_b64_tr_b16 %0,%1 offset:%c2":"=&v"(hi[ks]):"v"(vb),"i"(d0*4096+ks*1024+512):"memory");}
    asm volatile("s_waitcnt lgkmcnt(0)":::"memory");SBAR();
    #define PK(k) (bf16x8){lo[k][0],lo[k][1],lo[k][2],lo[k][3],hi[k][0],hi[k][1],hi[k][2],hi[k][3]}
    o[d0]=__builtin_amdgcn_mfma_f32_32x32x16_bf16(pa0,PK(0),o[d0],0,0,0);
    o[d0]=__builtin_amdgcn_mfma_f32_32x32x16_bf16(pa1,PK(1),o[d0],0,0,0);
    o[d0]=__builtin_amdgcn_mfma_f32_32x32x16_bf16(pa2,PK(2),o[d0],0,0,0);
    o[d0]=__builtin_amdgcn_mfma_f32_32x32x16_bf16(pa3,PK(3),o[d0],0,0,0);
    #undef PK
  }
}

#ifndef ATTN_STORE16
#define ATTN_STORE16(p,v) (*(u32x4*)(p)=(v))
#endif
template<int THRL> __device__ __forceinline__ void attn_unit(int b,int h,int qb,const bf16*Q,const bf16*__restrict__ K,const bf16*__restrict__ V,bf16*O,char*shm){
  int tid_=threadIdx.x; asm volatile("":"+v"(tid_));
  const int tid=tid_,lane=tid&63,r32=lane&31,hi=lane>>5; const int wid=__builtin_amdgcn_readfirstlane(tid>>6);
  const long rowbase=(long)b*SEQ; const int q0=qb*QB;
  const bf16*Qw=Q+(rowbase+q0+wid*QBLK)*DM+h*D;
  const bf16*Kh=K+rowbase*DM+h*D,*Vh=V+rowbase*DM+h*D;
  const unsigned lds0=(unsigned)(uintptr_t)shm;
  float*wsf=(float*)(shm+LDS_WS)+wid*64;
  const bf16*ksrc=Kh+(long)lane*DM+wid*8;
  const bf16*vsrc=Vh+(long)(16*(wid&3)+(lane>>2))*DM+(wid>>2)*32+(lane&3)*8;
  const unsigned kdst=lds0+LDS_K+wid*1024, vdst=lds0+LDS_V+wid*1024;
  #define DMA_K(t,slot) glds16(ksrc+(long)(t)*KVBLK*DM,(unsigned)__builtin_amdgcn_readfirstlane(kdst+(slot)))
  #define DMA_V(t,slot) glds16(vsrc+(long)(t)*KVBLK*DM,(unsigned)__builtin_amdgcn_readfirstlane(vdst+(slot)))
  const int vb0=(int)(lds0+LDS_V)+((lane>>4)&1)*32+(lane&3)*8+(4*hi+((lane&15)>>2))*64;
  const char*Kbase=shm+LDS_K; bf16x8 kf[8];
  const lds_cptr shm3=(lds_cptr)shm; const lds_cptr kp0=shm3+LDS_K+hi*1024+r32*16; const lds_cptr vp0=shm3+LDS_V+((lane>>4)&1)*32+(lane&3)*8+(4*hi+((lane&15)>>2))*64;
  const int NT=(q0+QB)/KVBLK;
  DMA_K(0,0);DMA_V(0,0);DMA_K(1,SLOTB);
  bf16x8 qr[4];
  #pragma unroll
  for(int d0=0;d0<4;++d0)qr[d0]=*reinterpret_cast<const bf16x8*>(&Qw[(long)r32*DM+d0*16+hi*8]);
  float mhat=0.f,l_reg=0.f;f32x16 o[2];o[0]=f32x16{};o[1]=f32x16{};f32x16 negm=f32x16{};asm volatile("":"+v"(negm));
  const int qrel=wid*QBLK+r32;
  #define CMASK(P0,P1,t) do{int jb_=(t)-(NT-4); if(jb_>=0)cmask(P0,P1,jb_,qrel,hi);}while(0)
  bool resc=false;
  #define START(P0,P1) do{ const float rm=rowmax(P0,P1); resc=false; \
    { const float dl=rm; mhat=fadd_s(mhat,dl); \
      _Pragma("unroll") for(int r=0;r<16;++r){P0[r]=fsub_s(P0[r],dl);P1[r]=fsub_s(P1[r],dl);} \
      _Pragma("unroll") for(int r=0;r<16;++r)negm[r]=-mhat; asm volatile("":"+v"(negm)); } \
    _Pragma("unroll") for(int r=0;r<16;++r)P0[r]=__builtin_amdgcn_exp2f(P0[r]); }while(0)
  #define RESC() do{ if(resc){ asm volatile("s_waitcnt lgkmcnt(0)":::"memory"); \
      _Pragma("unroll") for(int d_=0;d_<2;++d_) _Pragma("unroll") for(int r=0;r<16;++r)o[d_][r]*=wsf[crow(r,hi)]; } }while(0)
  f32x16 pA0,pA1,pB0,pB1;
  int sl_prev=0,sl_cur=0,sl_next=SLOTB;
  #define ROT() do{sl_prev=sl_cur;sl_cur=sl_next;sl_next=(sl_next==(NSLOT-1)*SLOTB)?0:sl_next+SLOTB;}while(0)
  DMA_K(2,2*SLOTB);
  WAIT_BAR(3);
  qkt(pA0,pA1,Kbase,qr,negm,r32,hi);asm volatile("s_nop 15\n\ts_nop 7":"+v"(pA0),"+v"(pA1));CMASK(pA0,pA1,0);
  START(pA0,pA1);
  _Pragma("unroll") for(int r=0;r<16;++r)pA1[r]=__builtin_amdgcn_exp2f(pA1[r]);
  WAIT_BAR(0);
  DMA_K(3,0);DMA_V(1,SLOTB);
  ROT();
  kload8(kf,kp0+sl_cur);
  WAIT_BAR(2);
  s16x4 vlo[8],vhi[8]; u32x4 pw0,pw1,pw2,pw3;
  #define PKW(P,B) cvtpk_s(P[B],P[B+1])
  #define PAF(k) __builtin_bit_cast(bf16x8,pw##k)
  #define VFR(i) (bf16x8){vlo[i][0],vlo[i][1],vlo[i][2],vlo[i][3],vhi[i][0],vhi[i][1],vhi[i][2],vhi[i][3]}
  #define PIN(x) asm volatile("":"+v"(x))
  #define MX3(a,b,c) __builtin_fmaxf(__builtin_fmaxf((a),(b)),(c))
  #define GAPA(MF,A0,A1,A2,A3,W0,W1,PW) do{ MF; sacc+=A0; sacc+=A1; sacc+=A2; sacc+=A3; PIN(sacc); W0; W1; PIN(PW); SBAR(); }while(0)
  #define EX(v) __builtin_amdgcn_exp2f(v)
  #define GAPB(MF,X,B) do{ MF; X[B]=EX(X[B]); X[B+1]=EX(X[B+1]); X[B+2]=EX(X[B+2]); X[B+3]=EX(X[B+3]); PIN(X); SBAR(); }while(0)
  #define VRD(i) do{ vlo[i]=vtr(vp_+(((i)>>2)*4096+((i)&3)*1024)); vhi[i]=vtr(vp_+(((i)>>2)*4096+((i)&3)*1024+512)); }while(0)
  #define KRD(G,j) do{ if(G){ kload2(kf,kp0+sl_next,j); SBAR(); } }while(0)
  #define STEP(C0,C1,P0,P1,t,GK,GV,GL) do{ SBAR(); \
    const lds_cptr vp_=vp0+sl_prev; \
    VRD(0); SBAR(); float sacc=(P0[0]+P0[1]); \
    GAPA(C0=__builtin_amdgcn_mfma_f32_32x32x16_bf16(kf[0],qr[0],negm,0,0,0), P0[2],P0[3],P0[4],P0[5],     pw0[0]=PKW(P0,0), pw0[1]=PKW(P0,2), pw0); \
    VRD(4); SBAR(); GAPA(C1=__builtin_amdgcn_mfma_f32_32x32x16_bf16(kf[1],qr[0],negm,0,0,0), P0[6],P0[7],P0[8],P0[9],     pw0[2]=PKW(P0,4), pw0[3]=PKW(P0,6), pw0); \
    VRD(1); SBAR(); GAPA(C0=__builtin_amdgcn_mfma_f32_32x32x16_bf16(kf[2],qr[1],C0,0,0,0),   P0[10],P0[11],P0[12],P0[13], pw1[0]=PKW(P0,8), pw1[1]=PKW(P0,10), pw1); \
    VRD(5); SBAR(); GAPA(C1=__builtin_amdgcn_mfma_f32_32x32x16_bf16(kf[3],qr[1],C1,0,0,0),   P0[14],P0[15],P1[0],P1[1],   pw1[2]=PKW(P0,12),pw1[3]=PKW(P0,14), pw1); \
    VRD(2); SBAR(); GAPA(C0=__builtin_amdgcn_mfma_f32_32x32x16_bf16(kf[4],qr[2],C0,0,0,0),   P1[2],P1[3],P1[4],P1[5],     pw2[0]=PKW(P1,0), pw2[1]=PKW(P1,2), pw2); \
    VRD(6); SBAR(); GAPA(C1=__builtin_amdgcn_mfma_f32_32x32x16_bf16(kf[5],qr[2],C1,0,0,0),   P1[6],P1[7],P1[8],P1[9],     pw2[2]=PKW(P1,4), pw2[3]=PKW(P1,6), pw2); \
    VRD(3); SBAR(); GAPA(C0=__builtin_amdgcn_mfma_f32_32x32x16_bf16(kf[6],qr[3],C0,0,0,0),   P1[10],P1[11],P1[12],P1[13], pw3[0]=PKW(P1,8), pw3[1]=PKW(P1,10), pw3); \
    VRD(7); SBAR(); GAPA(C1=__builtin_amdgcn_mfma_f32_32x32x16_bf16(kf[7],qr[3],C1,0,0,0),   P1[14],P1[15],0.f,0.f,       pw3[2]=PKW(P1,12),pw3[3]=PKW(P1,14), pw3); \
    l_reg+=sacc; \
    if(GK){DMA_K((t)+3,sl_cur);} if(GV){DMA_V((t)+1,sl_next);} \
    CMASK(C0,C1,t); \
    { float a=MX3(C0[0],C0[1],C1[0]),b=MX3(C0[2],C0[3],C1[1]); a=MX3(a,C1[2],C1[3]); \
      _Pragma("unroll") for(int r=4;r<16;r+=4){a=MX3(a,C0[r],C0[r+1]);b=MX3(b,C0[r+2],C0[r+3]);a=MX3(a,C1[r],C1[r+1]);b=MX3(b,C1[r+2],C1[r+3]);} \
      float rm=__builtin_fmaxf(a,b); { auto rr=__builtin_amdgcn_permlane32_swap(__float_as_uint(rm),__float_as_uint(rm),false,false); rm=__builtin_fmaxf(__uint_as_float(rr[0]),__uint_as_float(rr[1])); } \
      resc=false; \
      if(__builtin_expect(__any(rm>(float)THRL),0)){ const float dl=__builtin_fmaxf(rm,0.f); mhat+=dl; \
        _Pragma("unroll") for(int r=0;r<16;++r){C0[r]-=dl;C1[r]-=dl;} \
        _Pragma("unroll") for(int r=0;r<16;++r)negm[r]=-mhat; asm volatile("":"+v"(negm)); \
        const float f=__builtin_amdgcn_exp2f(-dl); l_reg*=f; if(hi==0)wsf[r32]=f; resc=true; } } \
    SBAR(); \
    GAPB(o[0]=__builtin_amdgcn_mfma_f32_32x32x16_bf16(PAF(0),VFR(0),o[0],0,0,0), C0,0); \
    GAPB(o[1]=__builtin_amdgcn_mfma_f32_32x32x16_bf16(PAF(0),VFR(4),o[1],0,0,0), C0,4); \
    KRD(GL,0); GAPB(o[0]=__builtin_amdgcn_mfma_f32_32x32x16_bf16(PAF(1),VFR(1),o[0],0,0,0), C0,8); \
    KRD(GL,1); GAPB(o[1]=__builtin_amdgcn_mfma_f32_32x32x16_bf16(PAF(1),VFR(5),o[1],0,0,0), C0,12); \
    KRD(GL,2); GAPB(o[0]=__builtin_amdgcn_mfma_f32_32x32x16_bf16(PAF(2),VFR(2),o[0],0,0,0), C1,0); \
    KRD(GL,3); GAPB(o[1]=__builtin_amdgcn_mfma_f32_32x32x16_bf16(PAF(2),VFR(6),o[1],0,0,0), C1,4); \
    GAPB(o[0]=__builtin_amdgcn_mfma_f32_32x32x16_bf16(PAF(3),VFR(3),o[0],0,0,0), C1,8); \
    GAPB(o[1]=__builtin_amdgcn_mfma_f32_32x32x16_bf16(PAF(3),VFR(7),o[1],0,0,0), C1,12); \
    }while(0)
  int t=1;
  #undef CMASK
  #define CMASK(P0,P1,t) do{}while(0)
  for(;t+5<NT;t+=2){
    STEP(pB0,pB1,pA0,pA1,t,true,true,true);     WAIT_BAR(2); RESC(); ROT();
    STEP(pA0,pA1,pB0,pB1,t+1,true,true,true);   WAIT_BAR(2); RESC(); ROT();
  }
  #undef CMASK
  #define CMASK(P0,P1,t) do{int jb_=(t)-(NT-4); if(jb_>=0)cmask(P0,P1,jb_,qrel,hi);}while(0)
  #define ENDW(tt) do{ if((tt)+3<NT){WAIT_BAR(2);} else if((tt)+2<NT){WAIT_BAR(1);} else {WAIT_BAR(0);} }while(0)
  for(;t+1<NT;t+=2){
    STEP(pB0,pB1,pA0,pA1,t,(t+3<NT),(t+1<NT),(t+1<NT));       ENDW(t);   RESC(); ROT();
    STEP(pA0,pA1,pB0,pB1,t+1,(t+4<NT),(t+2<NT),(t+2<NT));     ENDW(t+1); RESC(); ROT();
  }
  STEP(pB0,pB1,pA0,pA1,NT-1,false,false,false); RESC();
  { float sacc=pB0[0]+pB0[1]; _Pragma("unroll") for(int r=2;r<16;++r)sacc+=pB0[r]; _Pragma("unroll") for(int r=0;r<16;++r)sacc+=pB1[r]; l_reg+=sacc;
    pw0=(u32x4){PKW(pB0,0),PKW(pB0,2),PKW(pB0,4),PKW(pB0,6)};pw1=(u32x4){PKW(pB0,8),PKW(pB0,10),PKW(pB0,12),PKW(pB0,14)};pw2=(u32x4){PKW(pB1,0),PKW(pB1,2),PKW(pB1,4),PKW(pB1,6)};pw3=(u32x4){PKW(pB1,8),PKW(pB1,10),PKW(pB1,12),PKW(pB1,14)};
    SBAR(); pv(o,vb0+sl_cur,PAF(0),PAF(1),PAF(2),PAF(3)); }
  #undef PKW
  #undef PAF
  #undef VFR
  #undef PIN
  #undef MX3
  #undef GAPA
  #undef GAPB
  #undef EX
  #undef VRD
  #undef KRD
  #undef STEP
  #undef ENDW
  {auto rr=__builtin_amdgcn_permlane32_swap(__float_as_uint(l_reg),__float_as_uint(l_reg),false,false);l_reg=__uint_as_float(rr[0])+__uint_as_float(rr[1]);}
  if(hi==0)wsf[32+r32]=l_reg;asm volatile("s_waitcnt lgkmcnt(0)":::"memory");
  float rli[16];
  #pragma unroll
  for(int r=0;r<16;++r)rli[r]=__builtin_amdgcn_rcpf(wsf[32+crow(r,hi)]);
  bf16*Ow=O+(rowbase+q0+wid*QBLK)*DM+h*D;
  { bf16*stg=(bf16*)(shm+LDS_OST)+wid*2048;
    #pragma unroll
    for(int r=0;r<16;++r){const int orow=crow(r,hi);
      #pragma unroll
      for(int d0=0;d0<2;++d0)stg[orow*64+d0*32+r32]=__float2bfloat16(o[d0][r]*rli[r]);}
    asm volatile("s_waitcnt lgkmcnt(0)":::"memory");
    #pragma unroll
    for(int i=0;i<4;++i){const int row=i*8+(lane>>3),ch=lane&7; const u32x4 v=*(const u32x4*)(stg+row*64+ch*8); ATTN_STORE16(Ow+(long)row*DM+ch*8,v);} }
  asm volatile("s_waitcnt lgkmcnt(0)\n\ts_barrier":::"memory");
  #undef DMA_K
  #undef DMA_V
  #undef CMASK
  #undef START
  #undef RESC
  #undef ROT
}
constexpr int ATTN_LDS_BYTES=LDS_BYTES;
struct AttnTensors { const bf16* Q; const bf16* K; const bf16* V; bf16* O; };
struct AttnUnit { int bh; int qb; };
struct StaticOrder {
  int vcu;
  __device__ __forceinline__ explicit StaticOrder(int grid,int block):vcu((block%8)*(grid/8)+block/8){}
  __device__ __forceinline__ bool next(int i,AttnUnit&u)const{ if(i>=4)return false; const int s=vcu&7; u.bh=vcu>>3; u.qb=(i==0)?s:(i==1)?15-s:(i==2)?16+s:31-s; return true; }
  __device__ __forceinline__ void a_ready(const AttnUnit&)const{}
  __device__ __forceinline__ void done(const AttnUnit&)const{}
};
template<class Sched,int THRL=8> __device__ __forceinline__ void attn_phase(char*lds,const AttnTensors&T,const Sched&S){
  AttnUnit u;
  for(int i=0;S.next(i,u);++i){ S.a_ready(u); attn_unit<THRL>(u.bh/NHEAD,u.bh%NHEAD,u.qb,T.Q,T.K,T.V,T.O,lds); S.done(u); }
}
#undef SBAR
#undef WAIT_BAR
}

#include <hip/hip_cooperative_groups.h>
namespace cg = cooperative_groups;

#ifndef MK_SINGLE
#define MK_SINGLE 0
#endif

#define LAS __attribute__((address_space(3)))
typedef unsigned short bf16;
typedef unsigned v4u __attribute__((ext_vector_type(4)));
typedef unsigned v2u __attribute__((ext_vector_type(2)));
typedef float f32x4 __attribute__((ext_vector_type(4)));
typedef float f32x2 __attribute__((ext_vector_type(2)));
typedef float f32x16 __attribute__((ext_vector_type(16)));
typedef short bf16x8 __attribute__((ext_vector_type(8)));
typedef short s16x4 __attribute__((ext_vector_type(4)));

constexpr int BATCH = 2, SEQ = 8192, DM = 1024, T = BATCH * SEQ, FFN = 2816, PLED = 256, NLAYER = 4;
constexpr float NORM_EPS = 1e-6f;
constexpr int NWAVES = 8;
constexpr int LDS_BYTES = 147456;

constexpr size_t MiB = 1u << 20;
constexpr size_t WS_SMALL = 0;
constexpr size_t WS_ROPE = 4 * MiB;
constexpr size_t WS_W = 8 * MiB;
constexpr size_t WL_STRIDE = 19 * MiB;
constexpr size_t WL_FFN_IN = 0, WL_FFN_OUT = 11 * MiB, WL_PLE_GATE = 11 * MiB + MiB / 2 * 11, WL_PLE_PROJ = WL_PLE_GATE + 2 * MiB;
constexpr size_t WS_WMIX = WS_W + 4 * WL_STRIDE;
constexpr size_t WM_A_IN = 0, WM_A_GATE = 4 * MiB, WM_A_OUT = 8 * MiB, WM_B_QKV = 10 * MiB, WM_B_OUT = 16 * MiB, WM_C_QKV = 18 * MiB, WM_C_OUT = 24 * MiB, WM_D_QKV = 26 * MiB, WM_D_OUT = 32 * MiB;
constexpr size_t WS_XN = 118 * MiB;
constexpr size_t WS_BIG = 150 * MiB;
constexpr size_t WS_Y = 246 * MiB;
constexpr size_t WS_PP = 310 * MiB;
constexpr size_t WS_P16 = 342 * MiB;
constexpr size_t WS_END = 350 * MiB;
static_assert(WL_PLE_GATE == 16 * MiB + MiB / 2, "map");
constexpr size_t SM_C8SP = 0;
constexpr size_t SM_SCANP = 1 * MiB, SM_SCANH = 2 * MiB, SM_SCANC = 3 * MiB;

__device__ __forceinline__ float bf2f(unsigned short h) { return __uint_as_float(((unsigned)h) << 16); }
__device__ __forceinline__ unsigned pk2(float lo, float hi) { return pg8::cvt_pk_bf16(lo, hi); }
__device__ __forceinline__ float wave_sum(float v) {
#pragma unroll
    for (int o = 1; o < 64; o <<= 1) v += __shfl_xor(v, o);
    return v;
}
__device__ __forceinline__ float sigmoid_f(float v) { return 1.f / (1.f + __expf(-v)); }

namespace ep {
using pg8::Unit; using pg8::BM; using pg8::HALF;
struct EpiF32 {
    static constexpr bool PERM = true, AFTER_DRAIN = false;
    float* O; int ldc;
    __device__ __forceinline__ void operator()(const f32x4 (&acc)[2][2][4][2], const Unit& u, int wr, int wc, int fr, int fq) const {
        const int row0 = u.pm * BM + wr * 64 + fr, col0 = u.pn * BM + wc * 32 + 8 * fq;
#pragma unroll
        for (int ai = 0; ai < 2; ++ai)
#pragma unroll
            for (int m = 0; m < 4; ++m) { float* rowp = O + (size_t)(row0 + ai * HALF + m * 16) * ldc + col0;
#pragma unroll
                for (int bj = 0; bj < 2; ++bj) { *(f32x4*)(rowp + bj * HALF) = acc[ai][bj][m][0]; *(f32x4*)(rowp + bj * HALF + 4) = acc[ai][bj][m][1]; } }
    }
};
struct EpiBf16 {
    static constexpr bool PERM = true, AFTER_DRAIN = false;
    bf16* O; int ldc;
    __device__ __forceinline__ void operator()(const f32x4 (&acc)[2][2][4][2], const Unit& u, int wr, int wc, int fr, int fq) const {
        const int row0 = u.pm * BM + wr * 64 + fr, col0 = u.pn * BM + wc * 32 + 8 * fq;
#pragma unroll
        for (int ai = 0; ai < 2; ++ai)
#pragma unroll
            for (int m = 0; m < 4; ++m) { bf16* rowp = O + (size_t)(row0 + ai * HALF + m * 16) * ldc + col0;
#pragma unroll
                for (int bj = 0; bj < 2; ++bj) { const f32x4 v0 = acc[ai][bj][m][0], v1 = acc[ai][bj][m][1];
                    v4u w; w.x = pk2(v0[0], v0[1]); w.y = pk2(v0[2], v0[3]); w.z = pk2(v1[0], v1[1]); w.w = pk2(v1[2], v1[3]); *(v4u*)(rowp + bj * HALF) = w; } }
    }
};
struct EpiPleGate {
    static constexpr bool PERM = true, AFTER_DRAIN = false;
    float* O; const bf16* PP; const float* bias;
    __device__ __forceinline__ void operator()(const f32x4 (&acc)[2][2][4][2], const Unit& u, int wr, int wc, int fr, int fq) const {
        const int row0 = u.pm * BM + wr * 64 + fr, col0 = u.pn * BM + wc * 32 + 8 * fq;
#pragma unroll
        for (int bj = 0; bj < 2; ++bj) {
            const f32x4 b0 = *(const f32x4*)(bias + col0 + bj * HALF), b1 = *(const f32x4*)(bias + col0 + bj * HALF + 4);
#pragma unroll
            for (int ai = 0; ai < 2; ++ai)
#pragma unroll
                for (int m = 0; m < 4; ++m) { const size_t off = (size_t)(row0 + ai * HALF + m * 16) * DM + col0 + bj * HALF;
                    const v4u pw = *(const v4u*)(PP + off);
                    const f32x4 v0 = acc[ai][bj][m][0] + b0, v1 = acc[ai][bj][m][1] + b1;
                    f32x4 o0, o1;
                    o0[0] = sigmoid_f(v0[0]) * __uint_as_float(pw.x << 16); o0[1] = sigmoid_f(v0[1]) * __uint_as_float(pw.x & 0xffff0000u);
                    o0[2] = sigmoid_f(v0[2]) * __uint_as_float(pw.y << 16); o0[3] = sigmoid_f(v0[3]) * __uint_as_float(pw.y & 0xffff0000u);
                    o1[0] = sigmoid_f(v1[0]) * __uint_as_float(pw.z << 16); o1[1] = sigmoid_f(v1[1]) * __uint_as_float(pw.z & 0xffff0000u);
                    o1[2] = sigmoid_f(v1[2]) * __uint_as_float(pw.w << 16); o1[3] = sigmoid_f(v1[3]) * __uint_as_float(pw.w & 0xffff0000u);
                    *(f32x4*)(O + off) = o0; *(f32x4*)(O + off + 4) = o1; }
        }
    }
};
struct EpiSwiglu {
    static constexpr bool PERM = true, AFTER_DRAIN = false;
    bf16* H;
    __device__ __forceinline__ void operator()(const f32x4 (&acc)[2][2][4][2], const Unit& u, int wr, int wc, int fr, int fq) const {
        const int row0 = u.pm * BM + wr * 64 + fr, hc0 = u.pn * 128 + wc * 16 + 4 * fq;
#pragma unroll
        for (int ai = 0; ai < 2; ++ai)
#pragma unroll
            for (int m = 0; m < 4; ++m) { bf16* rowp = H + (size_t)(row0 + ai * HALF + m * 16) * FFN + hc0;
#pragma unroll
                for (int bj = 0; bj < 2; ++bj) { const f32x4 g = acc[ai][bj][m][0], v = acc[ai][bj][m][1];
                    f32x4 o;
#pragma unroll
                    for (int e = 0; e < 4; ++e) o[e] = g[e] * sigmoid_f(g[e]) * v[e];
                    v2u w; w.x = pk2(o[0], o[1]); w.y = pk2(o[2], o[3]); *(v2u*)(rowp + bj * 64) = w; } }
    }
};
struct EpiQKV {
    static constexpr bool PERM = true, AFTER_DRAIN = false;
    bf16* O; size_t part_stride; const float* rope; int use_rope; float qscale;
    __device__ __forceinline__ void operator()(const f32x4 (&acc)[2][2][4][2], const Unit& u, int wr, int wc, int fr, int fq) const {
        const int part = u.pn >> 2; bf16* base = O + (size_t)part * part_stride;
        const int row0 = u.pm * BM + wr * 64 + fr, col0 = (u.pn & 3) * BM + wc * 32 + 8 * fq;
        const float sc = part == 0 ? qscale : 1.f;
        const int i0 = 4 * (4 * (wc & 1) + fq);
        const bool rp = use_rope && part < 2;
#pragma unroll
        for (int ai = 0; ai < 2; ++ai)
#pragma unroll
            for (int m = 0; m < 4; ++m) { const int row = row0 + ai * HALF + m * 16; bf16* rowp = base + (size_t)row * DM + col0;
                f32x4 cs = {1.f, 1.f, 1.f, 1.f}, sn = {0.f, 0.f, 0.f, 0.f};
                if (rp) { cs = *(const f32x4*)(rope + (size_t)row * 64 + i0); sn = *(const f32x4*)(rope + (size_t)row * 64 + 32 + i0); }
#pragma unroll
                for (int bj = 0; bj < 2; ++bj) { const f32x4 a = acc[ai][bj][m][0], b = acc[ai][bj][m][1];
                    f32x4 o0, o1;
                    if (part < 2) { o0 = (a * cs - b * sn) * sc; o1 = (b * cs + a * sn) * sc; } else { o0 = a; o1 = b; }
                    v4u w; w.x = pk2(o0[0], o0[1]); w.y = pk2(o0[2], o0[3]); w.z = pk2(o1[0], o1[1]); w.w = pk2(o1[2], o1[3]); *(v4u*)(rowp + bj * HALF) = w; } }
    }
};
struct EpiLruIn {
    static constexpr bool PERM = true, AFTER_DRAIN = false;
    bf16* YG; bf16* XB;
    __device__ __forceinline__ float gelu_t(float v) const { const float uu = 0.7978845608028654f * (v + 0.044715f * v * v * v); const float e = __expf(2.f * uu); const float th = 1.f - 2.f / (e + 1.f); return 0.5f * v * (1.f + th); }
    __device__ __forceinline__ void operator()(const f32x4 (&acc)[2][2][4][2], const Unit& u, int wr, int wc, int fr, int fq) const {
        const bool gl = u.pn < 4; bf16* base = gl ? YG : XB;
        const int row0 = u.pm * BM + wr * 64 + fr, col0 = (u.pn & 3) * BM + wc * 32 + 8 * fq;
#pragma unroll
        for (int ai = 0; ai < 2; ++ai)
#pragma unroll
            for (int m = 0; m < 4; ++m) { bf16* rowp = base + (size_t)(row0 + ai * HALF + m * 16) * DM + col0;
#pragma unroll
                for (int bj = 0; bj < 2; ++bj) { f32x4 v0 = acc[ai][bj][m][0], v1 = acc[ai][bj][m][1];
                    if (gl) {
#pragma unroll
                        for (int e = 0; e < 4; ++e) { v0[e] = gelu_t(v0[e]); v1[e] = gelu_t(v1[e]); } }
                    v4u w; w.x = pk2(v0[0], v0[1]); w.y = pk2(v0[2], v0[3]); w.z = pk2(v1[0], v1[1]); w.w = pk2(v1[2], v1[3]); *(v4u*)(rowp + bj * HALF) = w; } }
    }
};
struct EpiLruGate {
    static constexpr bool PERM = true, AFTER_DRAIN = false;
    float* Aa; float* Bb; const bf16* XC; const float* br; const float* bi; const float* c8sp;
    __device__ __forceinline__ void operator()(const f32x4 (&acc)[2][2][4][2], const Unit& u, int wr, int wc, int fr, int fq) const {
        const int row0 = u.pm * BM + wr * 64 + fr, c0 = u.pn * 128 + wc * 16 + 4 * fq;
#pragma unroll
        for (int bj = 0; bj < 2; ++bj) { const int c = c0 + bj * 64;
            const f32x4 vbr = *(const f32x4*)(br + c), vbi = *(const f32x4*)(bi + c), vsp = *(const f32x4*)(c8sp + c);
#pragma unroll
            for (int ai = 0; ai < 2; ++ai)
#pragma unroll
                for (int m = 0; m < 4; ++m) { const size_t off = (size_t)(row0 + ai * HALF + m * 16) * DM + c;
                    const v2u xw = *(const v2u*)(XC + off);
                    float xc[4] = {__uint_as_float(xw.x << 16), __uint_as_float(xw.x & 0xffff0000u), __uint_as_float(xw.y << 16), __uint_as_float(xw.y & 0xffff0000u)};
                    const f32x4 pr = acc[ai][bj][m][0] + vbr, pi = acc[ai][bj][m][1] + vbi;
                    f32x4 av, bv;
#pragma unroll
                    for (int e = 0; e < 4; ++e) { const float r = sigmoid_f(pr[e]), ig = sigmoid_f(pi[e]); const float la = -r * vsp[e];
                        av[e] = __expf(la); bv[e] = sqrtf(-expm1f(2.f * la)) * ig * xc[e]; }
                    *(f32x4*)(Aa + off) = av; *(f32x4*)(Bb + off) = bv; }
        }
    }
};
}

namespace sa {
#define MFMA32(a, b, c) __builtin_amdgcn_mfma_f32_32x32x16_bf16((a), (b), (c), 0, 0, 0)
constexpr int VROW = 144;
constexpr int WAVE_LDS = 32 * VROW + 512;
__device__ __forceinline__ int crow(int r, int hi) { return (r & 3) + 8 * (r >> 2) + 4 * hi; }
typedef float f32x2_t __attribute__((ext_vector_type(2))); typedef __bf16 bf16x2_t __attribute__((ext_vector_type(2)));
__device__ __forceinline__ unsigned cvtpk(float lo, float hi) { f32x2_t v = {lo, hi}; bf16x2_t b = __builtin_convertvector(v, bf16x2_t); return __builtin_bit_cast(unsigned, b); }
__device__ __forceinline__ bf16x8 pack8(const f32x16& x, int s) {
    v4u p; p.x = cvtpk(x[8 * s], x[8 * s + 1]); p.y = cvtpk(x[8 * s + 2], x[8 * s + 3]); p.z = cvtpk(x[8 * s + 4], x[8 * s + 5]); p.w = cvtpk(x[8 * s + 6], x[8 * s + 7]);
    return __builtin_bit_cast(bf16x8, p);
}
typedef short v4i16_t __attribute__((ext_vector_type(4)));
__device__ __forceinline__ s16x4 vtr(LAS const char* p) { return __builtin_bit_cast(s16x4, __builtin_amdgcn_ds_read_tr16_b64_v4i16((LAS v4i16_t*)p)); }
__device__ __forceinline__ void pv_tile(f32x16 (&o)[2], const f32x16& p, LAS const char* vl, int lane) {
    const int h = lane >> 5, blk = (lane >> 4) & 1, q4 = (lane & 15) >> 2, p4 = lane & 3;
    bf16x8 pa[2]; pa[0] = pack8(p, 0); pa[1] = pack8(p, 1);
#pragma unroll
    for (int d0 = 0; d0 < 2; ++d0)
#pragma unroll
        for (int s = 0; s < 2; ++s) {
            LAS const char* a = vl + (16 * s + 4 * h + q4) * VROW + (32 * d0 + 16 * blk + 4 * p4) * 2;
            const s16x4 lo = vtr(a), hi = vtr(a + 8 * VROW);
            const bf16x8 vb = __builtin_shufflevector(lo, hi, 0, 1, 2, 3, 4, 5, 6, 7);
            o[d0] = MFMA32(pa[s], vb, o[d0]);
        }
}
template <class RowF> __device__ __forceinline__ void store_o(const f32x16 (&o)[2], RowF rowf, int lane) {
    const int r = lane & 31, h = lane >> 5;
#pragma unroll
    for (int i = 0; i < 16; ++i) { bf16* rp = rowf(crow(i, h));
#pragma unroll
        for (int d0 = 0; d0 < 2; ++d0) rp[32 * d0 + r] = (bf16)(cvtpk(o[d0][i], 0.f) & 0xffffu); }
}

__device__ __forceinline__ void stick_task(const bf16* Q, const bf16* K, const bf16* V, bf16* O, int b, int head, int qg, LAS char* wl, int lane) {
    const int r = lane & 31, h = lane >> 5;
    const size_t rb = (size_t)b * SEQ;
    const bf16* qp = Q + (rb + 32 * qg + r) * DM + head * 64 + 8 * h;
    bf16x8 qf[4];
#pragma unroll
    for (int s = 0; s < 4; ++s) qf[s] = *(const bf16x8*)(qp + 16 * s);
    f32x16 o[2]; o[0] = f32x16{}; o[1] = f32x16{};
    float R = 0.f;
    const int qpos = 32 * qg + r;
    for (int kt = qg; kt >= 0; --kt) {
        const bf16* kp = K + (rb + 32 * kt + r) * DM + head * 64 + 8 * h;
        bf16x8 kf[4];
#pragma unroll
        for (int s = 0; s < 4; ++s) kf[s] = *(const bf16x8*)(kp + 16 * s);
        v4u vv[4];
#pragma unroll
        for (int i = 0; i < 4; ++i) vv[i] = *(const v4u*)(V + (rb + 32 * kt + (lane >> 3) + 8 * i) * DM + head * 64 + (lane & 7) * 8);
        f32x16 st = f32x16{};
#pragma unroll
        for (int s = 0; s < 4; ++s) st = MFMA32(kf[s], qf[s], st);
#pragma unroll
        for (int i = 0; i < 4; ++i) *(LAS v4u*)(wl + ((lane >> 3) + 8 * i) * VROW + (lane & 7) * 16) = vv[i];
        float sp[16]; const int kb = 32 * kt + 4 * h;
#pragma unroll
        for (int i = 0; i < 16; ++i) { const float z = st[i]; const bool valid = (kb + (i & 3) + 8 * (i >> 2)) < qpos;
            const float v = fmaxf(z, 0.f) + __logf(1.f + __expf(-fabsf(z))); sp[i] = valid ? v : 0.f; }
        float Tg[4];
#pragma unroll
        for (int g = 0; g < 4; ++g) { sp[4 * g + 2] += sp[4 * g + 3]; sp[4 * g + 1] += sp[4 * g + 2]; sp[4 * g] += sp[4 * g + 1]; Tg[g] = sp[4 * g]; }
        float Tp[4], U[4];
#pragma unroll
        for (int g = 0; g < 4; ++g) { Tp[g] = __shfl_xor(Tg[g], 32); U[g] = Tg[g] + Tp[g]; }
        float W = R; f32x16 att;
#pragma unroll
        for (int g = 3; g >= 0; --g) { const float off = W + (h == 0 ? Tp[g] : 0.f);
#pragma unroll
            for (int e = 0; e < 4; ++e) { const int i = 4 * g + e; const bool valid = (kb + e + 8 * g) < qpos; const float a = __expf(st[i] - (off + sp[i])); att[i] = valid ? a : 0.f; }
            W += U[g]; }
        R = W;
        pv_tile(o, att, wl, lane);
        if (__all(R >= 100.f)) break;
    }
    bf16* ob = O + (rb + 32 * qg) * DM + head * 64;
    store_o(o, [&](int q) { return ob + (size_t)q * DM; }, lane);
}

__device__ __forceinline__ void dilated_task(const bf16* Q, const bf16* K, const bf16* V, bf16* O, int b, int head, int r16, int tg, LAS char* wl, int lane) {
    const int r = lane & 31, h = lane >> 5;
    const size_t rb = (size_t)b * SEQ;
    const int tau0 = 32 * tg, tauq = tau0 + r, tq = r16 + 16 * tauq;
    const bf16* qp = Q + (rb + tq) * DM + head * 64 + 8 * h;
    bf16x8 qf[4];
#pragma unroll
    for (int s = 0; s < 4; ++s) qf[s] = *(const bf16x8*)(qp + 16 * s);
    f32x16 o[2]; o[0] = f32x16{}; o[1] = f32x16{};
    float m = -1e30f, l = 0.f;
    LAS float* fs = (LAS float*)(wl + 32 * VROW);
    for (int br = 0; br < 3; ++br) {
        int d, rho, ks, qk, nt;
        if (br == 0) { d = 16; rho = r16; ks = tau0 - 128; qk = tauq; nt = 5; }
        else if (br == 1) { d = 4; rho = r16 & 3; const int b4 = r16 >> 2; ks = b4 + 4 * tau0 - 128; qk = b4 + 4 * tauq; nt = 8; }
        else { d = 1; rho = 0; ks = r16 + 16 * tau0 - 128; qk = tq; nt = 20; }
        for (int j = 0; j < nt; ++j) {
            const int k0 = ks + 32 * j;
            if (k0 + 31 < 0) continue;
            int kr = k0 + r; kr = kr < 0 ? 0 : kr; int tokk = rho + d * kr; tokk = tokk > SEQ - 1 ? SEQ - 1 : tokk;
            const bf16* kp = K + (rb + tokk) * DM + head * 64 + 8 * h;
            bf16x8 kf[4];
#pragma unroll
            for (int s = 0; s < 4; ++s) kf[s] = *(const bf16x8*)(kp + 16 * s);
            v4u vv[4];
#pragma unroll
            for (int i = 0; i < 4; ++i) { int kv = k0 + (lane >> 3) + 8 * i; kv = kv < 0 ? 0 : kv; int tv = rho + d * kv; tv = tv > SEQ - 1 ? SEQ - 1 : tv;
                vv[i] = *(const v4u*)(V + (rb + tv) * DM + head * 64 + (lane & 7) * 8); }
            f32x16 st = f32x16{};
#pragma unroll
            for (int s = 0; s < 4; ++s) st = MFMA32(kf[s], qf[s], st);
#pragma unroll
            for (int i = 0; i < 4; ++i) *(LAS v4u*)(wl + ((lane >> 3) + 8 * i) * VROW + (lane & 7) * 16) = vv[i];
            const int kk0 = k0 + 4 * h; float tm = -1e30f; unsigned vmask = 0u;
#pragma unroll
            for (int i = 0; i < 16; ++i) { const int kk = kk0 + (i & 3) + 8 * (i >> 2); const int dl = qk - kk; const bool valid = (kk >= 0) && (dl >= 0) && (dl <= 128);
                vmask |= valid ? (1u << i) : 0u; tm = valid ? fmaxf(tm, st[i]) : tm; }
            tm = fmaxf(tm, __shfl_xor(tm, 32));
            const float mn = fmaxf(m, tm); const float f = __expf(m - mn); m = mn;
            f32x16 p; float ps = 0.f;
#pragma unroll
            for (int i = 0; i < 16; ++i) { const float e = __expf(st[i] - mn); p[i] = ((vmask >> i) & 1u) ? e : 0.f; ps += p[i]; }
            l = l * f + ps;
            if (!__all(f == 1.f)) {
                if (h == 0) fs[r] = f;
#pragma unroll
                for (int g = 0; g < 4; ++g) { const f32x4 f4 = *(LAS const f32x4*)(fs + 8 * g + 4 * h);
#pragma unroll
                    for (int e = 0; e < 4; ++e) { o[0][4 * g + e] *= f4[e]; o[1][4 * g + e] *= f4[e]; } }
            }
            pv_tile(o, p, wl, lane);
        }
    }
    l += __shfl_xor(l, 32);
    if (h == 0) fs[64 + r] = 1.f / l;
#pragma unroll
    for (int g = 0; g < 4; ++g) { const f32x4 f4 = *(LAS const f32x4*)(fs + 64 + 8 * g + 4 * h);
#pragma unroll
        for (int e = 0; e < 4; ++e) { o[0][4 * g + e] *= f4[e]; o[1][4 * g + e] *= f4[e]; } }
    bf16* ob = O + (rb + r16 + 16 * tau0) * DM + head * 64;
    store_o(o, [&](int q) { return ob + (size_t)q * 16 * DM; }, lane);
}
}

__device__ __forceinline__ int dest_row(int kind, int n) {
    if (kind == 1) { if (n >= 2048) return n; const int hd = n & ~63, d = n & 63, dd = d & 31; return hd + 8 * (dd >> 2) + 4 * (d >> 5) + (dd & 3); }
    if (kind == 2) { const int up = n >= FFN, c = up ? n - FFN : n; return 8 * (c >> 2) + 4 * up + (c & 3); }
    return n;
}
__device__ __forceinline__ void transpose_item(const float* W, int K, int N, bf16* WT, int kind, LAS float* scr, int item, int lane) {
    const int nblk = N / 32, kb = item / nblk, nb = item % nblk, k0 = 64 * kb, n0 = 32 * nb;
#pragma unroll 8
    for (int i = 0; i < 32; ++i) { const int kk = 2 * i + (lane >> 5); scr[kk * 33 + (lane & 31)] = W[(size_t)(k0 + kk) * N + n0 + (lane & 31)]; }
    asm volatile("s_waitcnt lgkmcnt(0)" ::: "memory");
    const int c = lane & 7;
#pragma unroll
    for (int j = 0; j < 4; ++j) { const int n = (lane >> 3) + 8 * j; const LAS float* s = scr + (8 * c) * 33 + n;
        v4u o; o.x = pk2(s[0 * 33], s[1 * 33]); o.y = pk2(s[2 * 33], s[3 * 33]); o.z = pk2(s[4 * 33], s[5 * 33]); o.w = pk2(s[6 * 33], s[7 * 33]);
        *(v4u*)(WT + (size_t)dest_row(kind, n0 + n) * K + k0 + 8 * c) = o; }
    asm volatile("s_waitcnt lgkmcnt(0)" ::: "memory");
}
__device__ __forceinline__ void transpose_job(const float* W, int K, int N, bf16* WT, int kind, LAS float* scr, int gw, int NGW, int lane) {
    const int nitems = (K / 64) * (N / 32);
    for (int it = gw; it < nitems; it += NGW) transpose_item(W, K, N, WT, kind, scr, it, lane);
}
template <int MODE> __device__ __forceinline__ void row_phase(const float* Y, const float* xin, float* X, const float* gpost, const float* gnext, bf16* XN,
                                                               const float* psrc, bf16* pdst, int gw, int NGW, int lane) {
    for (int mrow = gw; mrow < T; mrow += NGW) {
        f32x4 xv[4];
        if (MODE == 0) {
#pragma unroll
            for (int j = 0; j < 4; ++j) xv[j] = ((const f32x4*)(xin + (size_t)mrow * DM))[64 * j + lane];
        } else {
            f32x4 y[4]; float ss = 0.f;
#pragma unroll
            for (int j = 0; j < 4; ++j) { y[j] = ((const f32x4*)(Y + (size_t)mrow * DM))[64 * j + lane]; ss += (y[j].x * y[j].x + y[j].y * y[j].y) + (y[j].z * y[j].z + y[j].w * y[j].w); }
            const float rs = rsqrtf(wave_sum(ss) * (1.f / DM) + NORM_EPS);
#pragma unroll
            for (int j = 0; j < 4; ++j) { const f32x4 g = ((const f32x4*)gpost)[64 * j + lane]; xv[j] = ((const f32x4*)(X + (size_t)mrow * DM))[64 * j + lane] + y[j] * rs * g; }
        }
#pragma unroll
        for (int j = 0; j < 4; ++j) ((f32x4*)(X + (size_t)mrow * DM))[64 * j + lane] = xv[j];
        if (MODE == 0 || MODE == 1) {
            float s2 = 0.f;
#pragma unroll
            for (int j = 0; j < 4; ++j) s2 += (xv[j].x * xv[j].x + xv[j].y * xv[j].y) + (xv[j].z * xv[j].z + xv[j].w * xv[j].w);
            const float rs2 = rsqrtf(wave_sum(s2) * (1.f / DM) + NORM_EPS);
#pragma unroll
            for (int j = 0; j < 4; ++j) { const f32x4 g = ((const f32x4*)gnext)[64 * j + lane]; const f32x4 o = xv[j] * rs2 * g;
                v2u w; w.x = pk2(o.x, o.y); w.y = pk2(o.z, o.w); ((v2u*)(XN + (size_t)mrow * DM))[64 * j + lane] = w; }
        } else if (MODE == 2) {
#pragma unroll
            for (int j = 0; j < 4; ++j) { v2u w; w.x = pk2(xv[j].x, xv[j].y); w.y = pk2(xv[j].z, xv[j].w); ((v2u*)(XN + (size_t)mrow * DM))[64 * j + lane] = w; }
        }
        if (psrc) { const f32x4 pv = ((const f32x4*)(psrc + (size_t)mrow * PLED))[lane]; v2u w; w.x = pk2(pv.x, pv.y); w.y = pk2(pv.z, pv.w); ((v2u*)(pdst + (size_t)mrow * PLED))[lane] = w; }
    }
}

struct Args { const void* in[33]; float* out; unsigned char* ws; int ph_lo, ph_hi; };
#define AS4 __attribute__((address_space(4)))
#define PH_BEGIN if (ph >= lo && ph < hi) { asm volatile("" : "+s"(kargp)); unsigned char* const ws = *(unsigned char* const AS4*)(kargp + 8 * 34); (void)ws; \
    int tid_ = threadIdx.x, bx_ = blockIdx.x; asm volatile("" : "+v"(tid_), "+s"(bx_)); const int tid = tid_, lane = tid & 63, G = gridDim.x, bx = bx_; (void)lane; (void)G; (void)bx;
#define PH_END   if (ph + 1 < hi) cg::this_grid().sync(); } ++ph;
#define DEF_GW const int vcu = (G % 8 == 0) ? (bx % 8) * (G / 8) + bx / 8 : bx; const int gw = vcu * NWAVES + wave, NGW = G * NWAVES; (void)gw; (void)NGW;
#define ARG_F(i) ((const float*)(*(const void* const AS4*)(kargp + 8 * (i))))
#define ARG_X (*(float* const AS4*)(kargp + 8 * 33))
#define B_XN ((bf16*)(ws + WS_XN))
#define B_BIG ((bf16*)(ws + WS_BIG))
#define B_Y ((float*)(ws + WS_Y))
#define B_PP ((bf16*)(ws + WS_PP))
#define B_P16 ((bf16*)(ws + WS_P16))
#define B_ROPE ((float*)(ws + WS_ROPE))
#define B_C8SP ((float*)(ws + WS_SMALL + SM_C8SP))
#define B_SCP ((float*)(ws + WS_SMALL + SM_SCANP))
#define B_SCH ((float*)(ws + WS_SMALL + SM_SCANH))
#define B_SCC ((float*)(ws + WS_SMALL + SM_SCANC))
#define B_WMIX (ws + WS_WMIX)
#define GLDS ((PG8_LAS unsigned char*)lds)
#ifndef GEMM_ONLY
#define GEMM_CALL(EPI) pg8::gemm_phase<EPI, pg8::StaticOrder, true, true>(GLDS, g_, S_, E);
#else
#define GEMM_CALL(EPI) if constexpr (__is_same(EPI, GEMM_ONLY)) pg8::gemm_phase<EPI, pg8::StaticOrder, true, true>(GLDS, g_, S_, E); else { (void)g_; (void)S_; (void)E; }
#endif
#define GEMM(EPI, E, Aptr, Bptr, Nn, Kk) do { int K_ = (Kk), N_ = (Nn); asm volatile("" : "+s"(K_), "+s"(N_)); pg8::Gemm g_{(const pg8::bf16_t*)(Aptr), (const pg8::bf16_t*)(Bptr), T, N_, K_}; pg8::StaticOrder S_; S_.init(T, N_, G, bx); GEMM_CALL(EPI) } while (0)

__global__ void __launch_bounds__(NWAVES * 64, 2) fwd_kernel(Args args) {
    extern __shared__ __attribute__((aligned(16))) unsigned char lds[];
    const int wave = __builtin_amdgcn_readfirstlane(threadIdx.x >> 6);
    const AS4 unsigned char* kargp = (const AS4 unsigned char*)__builtin_amdgcn_kernarg_segment_ptr();
    const int lo = *(const int AS4*)(kargp + 8 * 35), hi = *(const int AS4*)(kargp + 8 * 35 + 4);
    int ph = 0;

    PH_BEGIN
    {
        DEF_GW
        LAS float* scr = (LAS float*)((LAS char*)lds + wave * 16384);
#pragma nounroll
        for (int L = 0; L < NLAYER; ++L) {
            unsigned char* wl_ = ws + WS_W + L * WL_STRIDE;
            transpose_job(ARG_F(8) + (size_t)L * DM * 2 * FFN, DM, 2 * FFN, (bf16*)(wl_ + WL_FFN_IN), 2, scr, gw, NGW, lane);
            transpose_job(ARG_F(9) + (size_t)L * FFN * DM, FFN, DM, (bf16*)(wl_ + WL_FFN_OUT), 0, scr, gw, NGW, lane);
            transpose_job(ARG_F(10) + (size_t)L * DM * DM, DM, DM, (bf16*)(wl_ + WL_PLE_GATE), 0, scr, gw, NGW, lane);
            transpose_job(ARG_F(12) + (size_t)L * PLED * DM, PLED, DM, (bf16*)(wl_ + WL_PLE_PROJ), 0, scr, gw, NGW, lane);
        }
        transpose_job(ARG_F(13), DM, 2 * DM, (bf16*)(B_WMIX + WM_A_IN), 0, scr, gw, NGW, lane);
        transpose_job(ARG_F(21), DM, DM, (bf16*)(B_WMIX + WM_A_OUT), 0, scr, gw, NGW, lane);
#pragma nounroll
        for (int a = 0; a < 3; ++a) {
            transpose_job(ARG_F(22 + 2 * a + (a == 2 ? 0 : 0)), DM, 3 * DM, (bf16*)(B_WMIX + WM_B_QKV + a * 8 * MiB), 1, scr, gw, NGW, lane);
            transpose_job(ARG_F(a == 2 ? 32 : 23 + 2 * a), DM, DM, (bf16*)(B_WMIX + WM_B_OUT + a * 8 * MiB), 0, scr, gw, NGW, lane);
        }
        {
            const float* gr = ARG_F(16); const float* gi = ARG_F(18); bf16* GW = (bf16*)(B_WMIX + WM_A_GATE);
            for (int idx = bx * 512 + tid; idx < 2048 * 128; idx += G * 512) {
                const int pp = idx >> 7, kc = idx & 127; const int gate = (pp >> 2) & 1, c = (pp >> 3) * 4 + (pp & 3), nb = c >> 6, e = c & 63;
                v4u o = {0u, 0u, 0u, 0u};
                if ((kc >> 3) == nb) { const float* src = (gate ? gi : gr) + ((size_t)nb * 64 + (kc & 7) * 8) * 64 + e;
                    o.x = pk2(src[0], src[64]); o.y = pk2(src[128], src[192]); o.z = pk2(src[256], src[320]); o.w = pk2(src[384], src[448]); }
                *(v4u*)(GW + (size_t)pp * DM + kc * 8) = o;
            }
            const float* lam = ARG_F(20);
            for (int c = bx * 512 + tid; c < DM; c += G * 512) B_C8SP[c] = 8.f * log1pf(expf(-lam[c]));
        }
        {
            const int* positions = (const int*)ARG_F(2); float* ROPE = B_ROPE;
            for (int idx = bx * 512 + tid; idx < T * 32; idx += G * 512) {
                const int t = idx >> 5, i = idx & 31;
                constexpr float INVF[32] = {1.000000000e+00f, 7.498942614e-01f, 5.623413324e-01f, 4.216965139e-01f, 3.162277639e-01f, 2.371373773e-01f, 1.778279394e-01f, 1.333521307e-01f, 1.000000015e-01f, 7.498941571e-02f, 5.623413250e-02f, 4.216965288e-02f, 3.162277490e-02f, 2.371373773e-02f, 1.778279431e-02f, 1.333521493e-02f, 9.999999776e-03f, 7.498941850e-03f, 5.623413250e-03f, 4.216964822e-03f, 3.162277630e-03f, 2.371373586e-03f, 1.778279431e-03f, 1.333521446e-03f, 1.000000047e-03f, 7.498942432e-04f, 5.623413017e-04f, 4.216965172e-04f, 3.162277571e-04f, 2.371373703e-04f, 1.778279402e-04f, 1.333521504e-04f};
                const float ang = (float)positions[t] * INVF[i];
                const double turns = (double)ang * 0.15915494309189535; const float fr = (float)(turns - __builtin_rint(turns));
                ROPE[(size_t)t * 64 + i] = __builtin_amdgcn_cosf(fr); ROPE[(size_t)t * 64 + 32 + i] = __builtin_amdgcn_sinf(fr);
            }
        }
        row_phase<0>(nullptr, ARG_F(0), ARG_X, nullptr, ARG_F(3), B_XN, nullptr, nullptr, gw, NGW, lane);
    }
    PH_END

#pragma nounroll
    for (int L = 0; L < NLAYER; ++L) {
        if (L == 0) {
            PH_BEGIN { ep::EpiLruIn E{B_PP, B_BIG + (size_t)T * DM}; GEMM(ep::EpiLruIn, E, B_XN, B_WMIX + WM_A_IN, 2 * DM, DM); } PH_END
            PH_BEGIN {
                DEF_GW
                const float* cw = ARG_F(14); const float* cb = ARG_F(15); const bf16* XB = B_BIG + (size_t)T * DM; bf16* XC = B_BIG;
                for (int mrow = gw; mrow < T; mrow += NGW) { const int s = mrow & (SEQ - 1);
#pragma unroll
                    for (int j = 0; j < 4; ++j) { const int c = (64 * j + lane) * 4; f32x4 a = *(const f32x4*)(cb + c);
#pragma unroll
                        for (int tap = 0; tap < 4; ++tap) { if (s - 3 + tap >= 0) { const v2u xw = *(const v2u*)(XB + (size_t)(mrow - 3 + tap) * DM + c); const f32x4 w = *(const f32x4*)(cw + tap * DM + c);
                                a[0] += w[0] * __uint_as_float(xw.x << 16); a[1] += w[1] * __uint_as_float(xw.x & 0xffff0000u); a[2] += w[2] * __uint_as_float(xw.y << 16); a[3] += w[3] * __uint_as_float(xw.y & 0xffff0000u); } }
                        v2u o; o.x = pk2(a[0], a[1]); o.y = pk2(a[2], a[3]); *(v2u*)(XC + (size_t)mrow * DM + c) = o; } }
            } PH_END
            PH_BEGIN { ep::EpiLruGate E{B_Y, (float*)(B_BIG + (size_t)T * DM), B_BIG, ARG_F(17), ARG_F(19), B_C8SP}; GEMM(ep::EpiLruGate, E, B_BIG, B_WMIX + WM_A_GATE, 2 * DM, DM); } PH_END
            PH_BEGIN {
                const float* Aa = B_Y; const float* Bb = (const float*)(B_BIG + (size_t)T * DM);
                for (int u = bx; u < 256; u += G) { const size_t t0 = (size_t)u * 64; f32x2 P = {1.f, 1.f}, H = {0.f, 0.f};
#pragma unroll 8
                    for (int i = 0; i < 64; ++i) { const f32x2 a = *(const f32x2*)(Aa + (t0 + i) * DM + 2 * tid), b = *(const f32x2*)(Bb + (t0 + i) * DM + 2 * tid); H = a * H + b; P = P * a; }
                    *(f32x2*)(B_SCP + (size_t)u * DM + 2 * tid) = P; *(f32x2*)(B_SCH + (size_t)u * DM + 2 * tid) = H; }
            } PH_END
            PH_BEGIN {
                const float* SCP = B_SCP; const float* SCH = B_SCH; float* SCC = B_SCC;
                if (wave == 0) { for (int gid = bx * 64 + lane; gid < 2048; gid += G * 64) { const int b = gid >> 10, c = gid & 1023; float carry = 0.f;
#pragma unroll 8
                        for (int ch = 0; ch < 128; ++ch) { const size_t o = (size_t)(b * 128 + ch) * DM + c; SCC[o] = carry; carry = SCP[o] * carry + SCH[o]; } } }
            } PH_END
            PH_BEGIN {
                const float* Aa = B_Y; const float* Bb = (const float*)(B_BIG + (size_t)T * DM); const bf16* YG = B_PP; bf16* MO = B_XN;
                for (int u = bx; u < 256; u += G) { const size_t t0 = (size_t)u * 64; f32x2 H = *(const f32x2*)(B_SCC + (size_t)u * DM + 2 * tid);
#pragma unroll 8
                    for (int i = 0; i < 64; ++i) { const f32x2 a = *(const f32x2*)(Aa + (t0 + i) * DM + 2 * tid), b = *(const f32x2*)(Bb + (t0 + i) * DM + 2 * tid); H = a * H + b;
                        const unsigned yg = *(const unsigned*)(YG + (t0 + i) * DM + 2 * tid);
                        *(unsigned*)(MO + (t0 + i) * DM + 2 * tid) = pk2(H.x * __uint_as_float(yg << 16), H.y * __uint_as_float(yg & 0xffff0000u)); } }
            } PH_END
        } else {
            PH_BEGIN { ep::EpiQKV E{B_BIG, (size_t)T * DM, B_ROPE, L != 2, L == 3 ? attn_body::C2 : 0.125f}; GEMM(ep::EpiQKV, E, B_XN, B_WMIX + WM_B_QKV + (size_t)(L - 1) * 8 * MiB, 3 * DM, DM); } PH_END
            if (L == 1) {
                PH_BEGIN { DEF_GW LAS char* wl = (LAS char*)lds + wave * sa::WAVE_LDS;
                    for (int task = gw; task < 8192; task += NGW) { const int tg = task & 15, r16 = (task >> 4) & 15, head = (task >> 8) & 15, b = task >> 12;
#ifndef NO_DIL
                        sa::dilated_task(B_BIG, B_BIG + (size_t)T * DM, B_BIG + 2 * (size_t)T * DM, B_XN, b, head, r16, tg, wl, lane);
#endif
                    } } PH_END
            } else if (L == 2) {
                PH_BEGIN { DEF_GW LAS char* wl = (LAS char*)lds + wave * sa::WAVE_LDS;
                    for (int task = gw; task < 8192; task += NGW) { const int qg = 255 - (task & 255), head = (task >> 8) & 15, b = task >> 12;
#ifndef NO_STICK
                        sa::stick_task(B_BIG, B_BIG + (size_t)T * DM, B_BIG + 2 * (size_t)T * DM, B_XN, b, head, qg, wl, lane);
#endif
                    } } PH_END
            } else {
                PH_BEGIN {
                    DEF_GW
                    for (int i = 0; i < 2048; ++i) {
                        int unit;
                        if (G == 256) { if (i >= 8) break; const int s = vcu & 7, combo = (vcu >> 3) + 32 * (i >> 2), k = i & 3; const int qbb = k == 0 ? s : (k == 1 ? 15 - s : (k == 2 ? 16 + s : 31 - s)); unit = combo * 32 + qbb; }
                        else { unit = bx + i * G; if (unit >= 2048) break; }
                        const int qb = unit & 31, combo = unit >> 5, b = combo >> 5, je = combo & 31, j = je >> 1, e = je & 1;
#ifndef NO_ATTN
                        attn_body::attn_unit<8>(b, 0, qb, (const attn_body::bf16*)(B_BIG + j * 64), (const attn_body::bf16*)(B_BIG + (size_t)T * DM + j * 64),
                                                (const attn_body::bf16*)(B_BIG + 2 * (size_t)T * DM + (j >> 1) * 128 + e * 64), (attn_body::bf16*)((e ? (bf16*)B_Y : B_PP) + j * 64), (char*)lds);
#endif
                    }
                } PH_END
                PH_BEGIN {
                    DEF_GW
                    const float* subln = ARG_F(31);
                    const float lam_init = 0.8f - 0.6f * 0.40656965974059917f;
                    const float lam = __expf(wave_sum(ARG_F(27)[lane] * ARG_F(28)[lane])) - __expf(wave_sum(ARG_F(29)[lane] * ARG_F(30)[lane])) + lam_init;
                    const int h8 = lane >> 3, sub = lane & 7, e = sub >> 2, d0 = (sub & 3) * 16;
                    float gs[16];
#pragma unroll
                    for (int i = 0; i < 16; ++i) gs[i] = subln[e * 64 + d0 + i] * (1.f - lam_init);
                    const bf16* Oe = e ? (const bf16*)B_Y : (const bf16*)B_PP; bf16* MO = B_XN;
                    for (int mrow = gw; mrow < T; mrow += NGW) {
                        const bf16* p0 = Oe + (size_t)mrow * DM + (2 * h8) * 64 + d0; const bf16* p1 = p0 + 64;
                        const v4u a0 = *(const v4u*)p0, a1 = *(const v4u*)(p0 + 8), b0 = *(const v4u*)p1, b1 = *(const v4u*)(p1 + 8);
                        const unsigned aw[8] = {a0.x, a0.y, a0.z, a0.w, a1.x, a1.y, a1.z, a1.w}, bw[8] = {b0.x, b0.y, b0.z, b0.w, b1.x, b1.y, b1.z, b1.w};
                        float v[16]; float ss = 0.f;
#pragma unroll
                        for (int i = 0; i < 8; ++i) { v[2 * i] = __uint_as_float(aw[i] << 16) - lam * __uint_as_float(bw[i] << 16); v[2 * i + 1] = __uint_as_float(aw[i] & 0xffff0000u) - lam * __uint_as_float(bw[i] & 0xffff0000u);
                            ss += v[2 * i] * v[2 * i] + v[2 * i + 1] * v[2 * i + 1]; }
                        ss += __shfl_xor(ss, 1); ss += __shfl_xor(ss, 2); ss += __shfl_xor(ss, 4);
                        const float rs = rsqrtf(ss * (1.f / 128.f) + 1e-5f);
                        v4u w0, w1;
                        w0.x = pk2(v[0] * rs * gs[0], v[1] * rs * gs[1]); w0.y = pk2(v[2] * rs * gs[2], v[3] * rs * gs[3]); w0.z = pk2(v[4] * rs * gs[4], v[5] * rs * gs[5]); w0.w = pk2(v[6] * rs * gs[6], v[7] * rs * gs[7]);
                        w1.x = pk2(v[8] * rs * gs[8], v[9] * rs * gs[9]); w1.y = pk2(v[10] * rs * gs[10], v[11] * rs * gs[11]); w1.z = pk2(v[12] * rs * gs[12], v[13] * rs * gs[13]); w1.w = pk2(v[14] * rs * gs[14], v[15] * rs * gs[15]);
                        bf16* op = MO + (size_t)mrow * DM + h8 * 128 + e * 64 + d0;
                        *(v4u*)op = w0; *(v4u*)(op + 8) = w1;
                    }
                } PH_END
            }
        }
        PH_BEGIN { ep::EpiF32 E{B_Y, DM}; GEMM(ep::EpiF32, E, B_XN, B_WMIX + (L == 0 ? WM_A_OUT : WM_B_OUT + (size_t)(L - 1) * 8 * MiB), DM, DM); } PH_END
        PH_BEGIN { DEF_GW row_phase<1>(B_Y, nullptr, ARG_X, ARG_F(4) + L * DM, ARG_F(5) + L * DM, B_XN, ARG_F(1) + (size_t)L * T * PLED, B_P16, gw, NGW, lane); } PH_END
        PH_BEGIN { ep::EpiSwiglu E{B_BIG}; GEMM(ep::EpiSwiglu, E, B_XN, ws + WS_W + L * WL_STRIDE + WL_FFN_IN, 2 * FFN, DM); } PH_END
        PH_BEGIN { ep::EpiF32 E{B_Y, DM}; GEMM(ep::EpiF32, E, B_BIG, ws + WS_W + L * WL_STRIDE + WL_FFN_OUT, DM, FFN); } PH_END
        PH_BEGIN { ep::EpiBf16 E{B_PP, DM}; GEMM(ep::EpiBf16, E, B_P16, ws + WS_W + L * WL_STRIDE + WL_PLE_PROJ, DM, PLED); } PH_END
        PH_BEGIN { DEF_GW row_phase<2>(B_Y, nullptr, ARG_X, ARG_F(6) + L * DM, nullptr, B_XN, nullptr, nullptr, gw, NGW, lane); } PH_END
        PH_BEGIN { ep::EpiPleGate E{B_Y, B_PP, ARG_F(11) + L * DM}; GEMM(ep::EpiPleGate, E, B_XN, ws + WS_W + L * WL_STRIDE + WL_PLE_GATE, DM, DM); } PH_END
        PH_BEGIN { DEF_GW if (L < NLAYER - 1) row_phase<1>(B_Y, nullptr, ARG_X, ARG_F(7) + L * DM, ARG_F(3) + (L + 1) * DM, B_XN, nullptr, nullptr, gw, NGW, lane);
                   else row_phase<3>(B_Y, nullptr, ARG_X, ARG_F(7) + L * DM, nullptr, B_XN, nullptr, nullptr, gw, NGW, lane); } PH_END
    }
}

constexpr int N_PHASES = 1 + (6 + 8) + (2 + 8) + (2 + 8) + (3 + 8);

extern "C" void kernel_launch(void* const* d_in, const int* in_sizes, int n_in, void* d_out, int out_size, void* d_ws, size_t ws_size, hipStream_t stream) {
    static int grid = 0;
    if (grid == 0) {
        if (n_in != 33 || out_size != T * DM || ws_size < WS_END) { fprintf(stderr, "kernel_launch: unexpected shapes (n_in %d out %d ws %zu)\n", n_in, out_size, ws_size); grid = -1; return; }
        int dev = 0, cus = 0, per_cu = 0;
        hipGetDevice(&dev); hipDeviceGetAttribute(&cus, hipDeviceAttributeMultiprocessorCount, dev);
        hipFuncSetAttribute((const void*)fwd_kernel, hipFuncAttributeMaxDynamicSharedMemorySize, LDS_BYTES);
        hipOccupancyMaxActiveBlocksPerMultiprocessor(&per_cu, (const void*)fwd_kernel, NWAVES * 64, LDS_BYTES);
        (void)hipGetLastError();
        if (per_cu < 1) per_cu = 1;
        grid = cus * per_cu; if (grid > 256) grid = 256;
    }
    if (grid < 0) return;
    Args a{};
    for (int i = 0; i < 33; ++i) a.in[i] = d_in[i];
    a.out = (float*)d_out; a.ws = (unsigned char*)d_ws;
    const int total = N_PHASES;
#if MK_SINGLE
    a.ph_lo = 0; a.ph_hi = 1000;
    void* kargs[] = {&a};
    hipError_t e = hipLaunchCooperativeKernel((const void*)fwd_kernel, dim3(grid), dim3(NWAVES * 64), kargs, LDS_BYTES, stream);
    if (e != hipSuccess) fprintf(stderr, "cooperative launch failed: %s (grid %d)\n", hipGetErrorString(e), grid);
    (void)total;
#else
    for (int p = 0; p < total; ++p) { a.ph_lo = p; a.ph_hi = p + 1; hipLaunchKernelGGL(fwd_kernel, dim3(grid), dim3(NWAVES * 64), LDS_BYTES, stream, a); }
#endif
}
```
